# Optimizing an MI355X kernel written in HIP

```python
import jax, jax.numpy as jnp
from jax import lax
import numpy as np

D_MODEL = 1024
BATCH = 8
SEQ = 2048
DEPTH = 1
DEC_BATCH = 32
DEC_SEQ = 4
PAST_LEN = 16384
PAGE_SIZE = 128

A_WIDTH = D_MODEL // 2
A_GROUPS = 4
A_GROUP_DIM = A_WIDTH // A_GROUPS
CHUNK = 128
B_HEADS = 8
HEAD_DIM = 64
B_WIDTH = B_HEADS * HEAD_DIM
KV_HEADS = 2
GQA = B_HEADS // KV_HEADS
BLOCK = 64
N_SELECT = 16
WINDOW = 512
CMP_HIDDEN = HEAD_DIM
N_KV_SLOTS = 6
N_PAGED_SLOTS = 4
QBLOCK = 128
D_FF = ((8 * D_MODEL // 3) + 127) // 128 * 128
CONV_W = 3

EPS = 1e-6
NEG = -1e30
FORCE_SCORE = 1e4
PAD_POS = -(2 ** 30)
KV_COLS = N_KV_SLOTS * KV_HEADS * HEAD_DIM
IN_COLS = 2 * A_WIDTH + B_WIDTH + KV_COLS + 3 * B_HEADS + 2 * D_MODEL
SPLIT_IDX = (2 * A_WIDTH, 2 * A_WIDTH + B_WIDTH, 2 * A_WIDTH + B_WIDTH + KV_COLS,
             2 * A_WIDTH + B_WIDTH + KV_COLS + 3 * B_HEADS)

kernel_name = "hybrid_gmlp_nsa_convffn_adaln_step"


def rmsnorm(x, g):
    xf = x.astype(jnp.float32)
    y = xf * lax.rsqrt(jnp.mean(xf * xf, -1, keepdims=True) + EPS)
    return (y * g.astype(jnp.float32)).astype(x.dtype)


def layernorm(x, g, b):
    xf = x.astype(jnp.float32)
    xc = xf - jnp.mean(xf, -1, keepdims=True)
    y = xc * lax.rsqrt(jnp.mean(xc * xc, -1, keepdims=True) + EPS)
    return (y * g.astype(jnp.float32) + b.astype(jnp.float32)).astype(x.dtype)


def masked_softmax(s, mask):
    s = jnp.where(mask, s.astype(jnp.float32), NEG)
    m = jnp.max(s, -1, keepdims=True)
    e = jnp.where(mask, jnp.exp(s - m), 0.0)
    return e / jnp.maximum(jnp.sum(e, -1, keepdims=True), 1e-30)


def chunk_spatial_gating(u, vn, w_s, b_s):
    B, T, _ = u.shape
    tc = CHUNK if T % CHUNK == 0 else T
    nc = T // tc
    w = jnp.tril(w_s[:, :tc, :tc])
    vr = vn.reshape(B, nc, tc, A_GROUPS, A_GROUP_DIM)
    s = jnp.einsum('hts,bcshd->bcthd', w, vr) + b_s[:, :tc].T[None, None, :, :, None]
    return u * s.reshape(B, T, A_WIDTH)


def compress_blocks(rows, pe, w1, b1, w2, b2):
    x = rows + pe[None, None, :, None, :]
    h = jax.nn.gelu(jnp.einsum('bnikd,idh->bnkh', x, w1) + b1)
    return jnp.einsum('bnkh,hd->bnkd', h, w2) + b2


def nsa_attention(q, kv_rows, win_rows, win_pos, q_pos, gate_logits, cmp_pe, cmp_w1, cmp_b1, cmp_w2, cmp_b2):
    B, T = q.shape[:2]
    L = kv_rows.shape[1]
    nb = -(-L // BLOCK)
    rows = jnp.pad(kv_rows, ((0, 0), (0, nb * BLOCK - L), (0, 0), (0, 0), (0, 0)))
    rows = rows.reshape(B, nb, BLOCK, N_PAGED_SLOTS, KV_HEADS, HEAD_DIM)
    qg = q.reshape(B, T, KV_HEADS, GQA, HEAD_DIM) * (HEAD_DIM ** -0.5)
    blk = jnp.arange(nb, dtype=jnp.int32)

    kc = compress_blocks(rows[:, :, :, 0], cmp_pe[0], cmp_w1[0], cmp_b1[0], cmp_w2[0], cmp_b2[0])
    vc = compress_blocks(rows[:, :, :, 1], cmp_pe[1], cmp_w1[1], cmp_b1[1], cmp_w2[1], cmp_b2[1])
    avail = (blk[None, :] + 1) * BLOCK <= q_pos[:, None] + 1
    p_cmp = masked_softmax(jnp.einsum('btkgd,bnkd->btkgn', qg, kc), avail[None, :, None, None, :])
    o_cmp = jnp.einsum('btkgn,bnkd->btkgd', p_cmp.astype(vc.dtype), vc)

    cur = (q_pos // BLOCK)[:, None]
    imp = jnp.sum(p_cmp, axis=3)
    forced = (blk[None, :] == 0) | (blk[None, :] == cur) | (blk[None, :] == cur - 1)
    future = blk[None, :] > cur
    imp = jnp.where(forced[None, :, None, :], FORCE_SCORE, jnp.where(future[None, :, None, :], -1.0, imp))
    n_sel = min(N_SELECT, nb)
    _, sel_idx = lax.top_k(imp, n_sel)
    ks = jnp.moveaxis(rows[:, :, :, 2], 3, 1)
    vs = jnp.moveaxis(rows[:, :, :, 3], 3, 1)
    qb = QBLOCK if T % QBLOCK == 0 else T
    nq = T // qb
    head_ix = jnp.arange(KV_HEADS)[None, :, None]
    offs = jnp.arange(BLOCK, dtype=jnp.int32)

    def sel_block(args):
        qi, ii, pi, bi = args
        kg = ks[bi][head_ix, ii]
        vg = vs[bi][head_ix, ii]
        kpos = ii[..., None] * BLOCK + offs
        mask = (kpos <= pi[:, None, None, None]).reshape(qb, KV_HEADS, 1, n_sel * BLOCK)
        s = jnp.einsum('qkgd,qksid->qkgsi', qi, kg).reshape(qb, KV_HEADS, GQA, n_sel * BLOCK)
        p = masked_softmax(s, mask).reshape(qb, KV_HEADS, GQA, n_sel, BLOCK)
        return jnp.einsum('qkgsi,qksid->qkgd', p.astype(vg.dtype), vg)

    o_sel = lax.map(sel_block, (qg.reshape(B * nq, qb, KV_HEADS, GQA, HEAD_DIM),
                                sel_idx.reshape(B * nq, qb, KV_HEADS, n_sel),
                                jnp.tile(q_pos.reshape(nq, qb), (B, 1)),
                                jnp.repeat(jnp.arange(B, dtype=jnp.int32), nq)))
    o_sel = o_sel.reshape(B, T, KV_HEADS, GQA, HEAD_DIM)

    lw = win_rows.shape[1]
    q_off = lw - T
    span = WINDOW + qb
    wpad = jnp.pad(win_rows, ((0, 0), (WINDOW, 0), (0, 0), (0, 0), (0, 0)))
    ppad = jnp.concatenate([jnp.full((WINDOW,), PAD_POS, jnp.int32), win_pos])
    kidx = q_off + qb * jnp.arange(nq)[:, None] + jnp.arange(span)[None, :]
    kw = wpad[:, kidx]
    kpos = ppad[kidx]
    diff = q_pos.reshape(nq, qb)[:, :, None] - kpos[:, None, :]
    wmask = (diff >= 0) & (diff < WINDOW)
    s = jnp.einsum('bnqkgd,bnjkd->bnqkgj', qg.reshape(B, nq, qb, KV_HEADS, GQA, HEAD_DIM), kw[:, :, :, 0])
    p = masked_softmax(s, wmask[None, :, :, None, None, :])
    o_win = jnp.einsum('bnqkgj,bnjkd->bnqkgd', p.astype(kw.dtype), kw[:, :, :, 1]).reshape(B, T, KV_HEADS, GQA, HEAD_DIM)

    g = jax.nn.sigmoid(gate_logits.astype(jnp.float32)).reshape(B, T, 3, KV_HEADS, GQA, 1).astype(q.dtype)
    o = g[:, :, 0] * o_cmp + g[:, :, 1] * o_sel + g[:, :, 2] * o_win
    return o.reshape(B, T, B_WIDTH)


def decoder_layer(x, c, q_pos, past_rows, win_prev, win_prev_pos, conv_prev, params):
    (w_ada, b_ada, g_norm1, w_in, ln_v_g, ln_v_b, w_spatial, b_spatial,
     cmp_pe, cmp_w1, cmp_b1, cmp_w2, cmp_b2, w_branch_a, w_branch_b, w_out,
     g_norm2, w_up, w_conv, b_conv, w_down) = params
    B, T, _ = x.shape
    mod = jax.nn.silu(c) @ w_ada + b_ada
    shift1, scale1, gate1, shift2, scale2, gate2 = jnp.split(mod[:, None, :], 6, axis=-1)

    h = rmsnorm(x, g_norm1) * (1 + scale1) + shift1
    za, zq, zkv, zg, zm = jnp.split(h @ w_in, SPLIT_IDX, axis=-1)

    u, v = jnp.split(jax.nn.gelu(za), 2, axis=-1)
    vn = layernorm(v, ln_v_g, ln_v_b)
    ya = chunk_spatial_gating(u, vn, w_spatial, b_spatial)

    q = zq.reshape(B, T, B_HEADS, HEAD_DIM)
    kv_new = zkv.reshape(B, T, N_KV_SLOTS, KV_HEADS, HEAD_DIM)
    paged_new = kv_new[:, :, :N_PAGED_SLOTS]
    win_new = kv_new[:, :, N_PAGED_SLOTS:]
    if past_rows is None:
        kv_rows, win_rows, win_pos = paged_new, win_new, q_pos
    else:
        kv_rows = jnp.concatenate([past_rows, paged_new], axis=1)
        win_rows = jnp.concatenate([win_prev, win_new], axis=1)
        win_pos = jnp.concatenate([win_prev_pos, q_pos])
    yb = nsa_attention(q, kv_rows, win_rows, win_pos, q_pos, zg, cmp_pe, cmp_w1, cmp_b1, cmp_w2, cmp_b2)

    gate_a, gate_b = jnp.split(jax.nn.sigmoid(zm), 2, axis=-1)
    mixed = (gate_a * (ya @ w_branch_a) + gate_b * (yb @ w_branch_b)) @ w_out
    x = x + gate1 * mixed

    h2 = rmsnorm(x, g_norm2) * (1 + scale2) + shift2
    up = h2 @ w_up
    prev = jnp.zeros((B, CONV_W - 1, 2 * D_FF), up.dtype) if conv_prev is None else conv_prev
    upc = jnp.concatenate([prev, up], axis=1)
    conv = b_conv
    for k in range(CONV_W):
        conv = conv + w_conv[k] * upc[:, k:k + T]
    a, gv = jnp.split(conv, 2, axis=-1)
    x = x + gate2 * ((jax.nn.gelu(a) * gv) @ w_down)

    new_win = win_rows[:, -min(WINDOW, win_rows.shape[1]):]
    new_conv = upc[:, -(CONV_W - 1):]
    return x, paged_new, new_win, vn, new_conv


def setup_inputs(seed: int = 0) -> dict:
    key = jax.random.key(seed)
    ks = jax.random.split(key, 32)
    n_pages = PAST_LEN // PAGE_SIZE
    n_pool = (5 * DEC_BATCH * n_pages + 3) // 4
    lbuf = min(WINDOW, PAST_LEN)

    def nrm(k, shape, s):
        return s * jax.random.normal(k, shape, jnp.float32)

    page_table = jax.random.permutation(ks[5], n_pool)[:DEC_BATCH * n_pages].reshape(DEC_BATCH, n_pages).astype(jnp.int32)
    return {
        'x_prompt': nrm(ks[0], (BATCH, SEQ, D_MODEL), 1.0),
        'x_sample': nrm(ks[1], (DEC_BATCH, DEC_SEQ, D_MODEL), 1.0),
        'cache_kv': nrm(ks[2], (DEPTH, n_pool, PAGE_SIZE, N_PAGED_SLOTS, KV_HEADS, HEAD_DIM), 1.0),
        'state_kv_win': nrm(ks[3], (DEPTH, DEC_BATCH, lbuf, 2, KV_HEADS, HEAD_DIM), 1.0),
        'state_ffn_conv': nrm(ks[4], (DEPTH, DEC_BATCH, CONV_W - 1, 2 * D_FF), 1.0),
        'page_table': page_table,
        'c_prompt': nrm(ks[6], (BATCH, D_MODEL), 1.0),
        'c_sample': nrm(ks[7], (DEC_BATCH, D_MODEL), 1.0),
        'w_ada': nrm(ks[8], (DEPTH, D_MODEL, 6 * D_MODEL), 0.5 * D_MODEL ** -0.5),
        'b_ada': nrm(ks[9], (DEPTH, 6 * D_MODEL), 0.01),
        'g_norm1': 1.0 + nrm(ks[10], (DEPTH, D_MODEL), 0.02),
        'w_in': nrm(ks[11], (DEPTH, D_MODEL, IN_COLS), D_MODEL ** -0.5),
        'ln_v_g': 1.0 + nrm(ks[12], (DEPTH, A_WIDTH), 0.02),
        'ln_v_b': nrm(ks[13], (DEPTH, A_WIDTH), 0.02),
        'w_spatial': nrm(ks[14], (DEPTH, A_GROUPS, CHUNK, CHUNK), 0.5 * CHUNK ** -0.5),
        'b_spatial': 1.0 + nrm(ks[15], (DEPTH, A_GROUPS, CHUNK), 0.1),
        'cmp_pe': nrm(ks[16], (DEPTH, 2, BLOCK, HEAD_DIM), 0.1),
        'cmp_w1': nrm(ks[17], (DEPTH, 2, BLOCK, HEAD_DIM, CMP_HIDDEN), (BLOCK * HEAD_DIM) ** -0.5),
        'cmp_b1': nrm(ks[18], (DEPTH, 2, CMP_HIDDEN), 0.01),
        'cmp_w2': nrm(ks[19], (DEPTH, 2, CMP_HIDDEN, HEAD_DIM), CMP_HIDDEN ** -0.5),
        'cmp_b2': nrm(ks[20], (DEPTH, 2, HEAD_DIM), 0.01),
        'w_branch_a': nrm(ks[21], (DEPTH, A_WIDTH, D_MODEL), A_WIDTH ** -0.5),
        'w_branch_b': nrm(ks[22], (DEPTH, B_WIDTH, D_MODEL), B_WIDTH ** -0.5),
        'w_out': nrm(ks[23], (DEPTH, D_MODEL, D_MODEL), D_MODEL ** -0.5),
        'g_norm2': 1.0 + nrm(ks[24], (DEPTH, D_MODEL), 0.02),
        'w_up': nrm(ks[25], (DEPTH, D_MODEL, 2 * D_FF), D_MODEL ** -0.5),
        'w_conv': nrm(ks[26], (DEPTH, CONV_W, 2 * D_FF), CONV_W ** -0.5),
        'b_conv': nrm(ks[27], (DEPTH, 2 * D_FF), 0.01),
        'w_down': nrm(ks[28], (DEPTH, D_FF, D_MODEL), D_FF ** -0.5),
        'g_final': 1.0 + nrm(ks[29], (D_MODEL,), 0.02),
    }


def reference(x_prompt, x_sample, cache_kv, state_kv_win, state_ffn_conv, page_table, c_prompt, c_sample,
              w_ada, b_ada, g_norm1, w_in, ln_v_g, ln_v_b, w_spatial, b_spatial,
              cmp_pe, cmp_w1, cmp_b1, cmp_w2, cmp_b2, w_branch_a, w_branch_b, w_out,
              g_norm2, w_up, w_conv, b_conv, w_down, g_final):
    t_p = x_prompt.shape[1]
    t_s = x_sample.shape[1]
    dec_b = x_sample.shape[0]
    past_len = page_table.shape[1] * cache_kv.shape[2]
    lbuf = state_kv_win.shape[2]
    pos_p = jnp.arange(t_p, dtype=jnp.int32)
    pos_s = past_len + jnp.arange(t_s, dtype=jnp.int32)
    win_prev_pos = past_len - lbuf + jnp.arange(lbuf, dtype=jnp.int32)

    xp, xs = x_prompt, x_sample
    kv_p, kv_s, win_p, win_s, v_s, conv_p, conv_s = [], [], [], [], [], [], []
    for l in range(DEPTH):
        params = (w_ada[l], b_ada[l], g_norm1[l], w_in[l], ln_v_g[l], ln_v_b[l], w_spatial[l], b_spatial[l],
                  cmp_pe[l], cmp_w1[l], cmp_b1[l], cmp_w2[l], cmp_b2[l], w_branch_a[l], w_branch_b[l], w_out[l],
                  g_norm2[l], w_up[l], w_conv[l], b_conv[l], w_down[l])
        past = cache_kv[l][page_table].reshape(dec_b, past_len, N_PAGED_SLOTS, KV_HEADS, HEAD_DIM)
        xp, kvp, wp, _, cp = decoder_layer(xp, c_prompt, pos_p, None, None, None, None, params)
        xs, kvs, ws, vs, cs = decoder_layer(xs, c_sample, pos_s, past, state_kv_win[l], win_prev_pos,
                                            state_ffn_conv[l], params)
        kv_p.append(kvp); kv_s.append(kvs); win_p.append(wp); win_s.append(ws)
        v_s.append(vs); conv_p.append(cp); conv_s.append(cs)

    y_prompt = rmsnorm(xp, g_final)
    y_sample = rmsnorm(xs, g_final)
    return (y_prompt, y_sample, jnp.stack(kv_p), jnp.stack(kv_s), jnp.stack(win_p), jnp.stack(win_s),
            jnp.stack(v_s), jnp.stack(conv_p), jnp.stack(conv_s))
```

```cpp
#include <hip/hip_runtime.h>
#include <hip/hip_bf16.h>
#include <cstdio>
#include <cstdint>
#ifndef MK_DIAG_F32
#define MK_DIAG_F32 0
#endif
#ifndef MK_N_LAUNCHES
#define MK_N_LAUNCHES 1
#endif
#ifndef MK_REF_ATTN
#define MK_REF_ATTN 0
#endif
#ifndef MK_REF_GATING
#define MK_REF_GATING 0
#endif
namespace pg8 {
#define PG8_LAS __attribute__((address_space(3)))
typedef unsigned short bf16_t;
typedef short bf16x8 __attribute__((ext_vector_type(8)));
typedef float f32x4 __attribute__((ext_vector_type(4)));
typedef unsigned u32x4 __attribute__((ext_vector_type(4)));
constexpr int BM = 256, BK = 64, HALF = 128, HTB = HALF * BK * 2  , STAGE_BYTES = 8 * HTB, NXCD = 8, WGM = 8;

__host__ __device__ __forceinline__ int lds_byte(int r, int c) { const int st = (r >> 4) * 2 + (c >> 5), rr = r & 15, cc = c & 31, ob = rr * 64 + cc * 2; return st * 1024 + (ob ^ (((ob >> 9) & 1) << 5)); }
__host__ __device__ __forceinline__ void stage_rc(int b, int& R, int& C) { const int st = b / 1024, sb = b % 1024, swz = sb ^ (((sb >> 9) & 1) << 5); R = (st >> 1) * 16 + swz / 64; C = (st & 1) * 32 + (swz % 64) / 2; }
__host__ __device__ __forceinline__ int perm32(int rho) { const int n = rho >> 4, i = rho & 15; return 8 * (i >> 2) + 4 * n + (i & 3); }

struct Unit { int pm, pn; };
struct Gemm { const bf16_t* A; const bf16_t* Bt; int M, N, K; };

struct StaticOrder {
    int nM, nN, nwg, G, c;
    __host__ __device__ void init(int M, int N, int G_, int c_) { nM = M / BM; nN = N / BM; nwg = nM * nN; G = G_; c = c_; }
    __host__ __device__ bool next(int i, Unit& u) const {
        const long L = (long)i * G + c; if (L >= nwg) return false;
        int wgid = (int)L; { const int q = nwg / NXCD, r = nwg % NXCD, xcd = wgid % NXCD, off = wgid / NXCD; wgid = (xcd < r ? xcd * (q + 1) : r * (q + 1) + (xcd - r) * q) + off; }
        const int nig = WGM * nN, gid = wgid / nig, fm = gid * WGM, gsz = (nM - fm) < WGM ? (nM - fm) : WGM;
        u.pm = fm + ((wgid % nig) % gsz); u.pn = (wgid % nig) / gsz; return true;
    }
    __device__ __forceinline__ void a_ready(const Unit&) const {}
    __device__ __forceinline__ void done(const Unit&) const {}
};

__device__ __forceinline__ unsigned cvt_pk_bf16(float lo, float hi) { unsigned r; asm volatile("v_cvt_pk_bf16_f32 %0, %1, %2" : "=v"(r) : "v"(lo), "v"(hi)); return r; }
typedef float f32x2 __attribute__((ext_vector_type(2)));
template <class Epi, class Sched, bool ALIGN_EPI = false, bool SP2 = false>
__device__ __forceinline__ void gemm_phase(PG8_LAS unsigned char* lds, const Gemm g, const Sched& S, const Epi& E) {
    const int tid = threadIdx.x, wid = __builtin_amdgcn_readfirstlane(tid >> 6), lane = tid & 63, wr = wid >> 2, wc = wid & 3, fr = lane & 15, fq = lane >> 4;
    const int K = g.K, nt = K / BK;
    unsigned voffA[2], voffB[2];
#pragma unroll
    for (int i = 0; i < 2; ++i) { int R, C; stage_rc(tid * 16 + i * 8192, R, C); const int Rb = Epi::PERM ? ((R & ~31) + perm32(R & 31)) : R;
        voffA[i] = (unsigned)(R * K + C) * 2u; voffB[i] = (unsigned)(Rb * K + C) * 2u; }
    const size_t kstep = (size_t)(BK * 2);
    const size_t hstep = (size_t)HALF * K * 2;
    const size_t tstep = 2 * hstep;
    const unsigned ldsw = (unsigned)wid * 1024u;
    const int aoff = lds_byte(wr * 64 + fr, fq * 8), boff = lds_byte(wc * 32 + fr, fq * 8);
#define PG8_SA(b, h) (((b) * 2 + (h)) * HTB)
#define PG8_SB(b, h) ((4 + (b) * 2 + (h)) * HTB)
#define PG8_STAGE(bufoff, gbase, voff) do { _Pragma("unroll") for (int _i = 0; _i < 2; ++_i) \
        __builtin_amdgcn_global_load_lds((const unsigned*)((const char*)(gbase) + (voff)[_i]), (PG8_LAS unsigned*)(lds + (bufoff) + ldsw + _i * 8192), 16, 0, 0); } while (0)
#define PG8_LDA(dst, b, h) do { _Pragma("unroll") for (int m = 0; m < 4; ++m) _Pragma("unroll") for (int k = 0; k < 2; ++k) dst[m][k] = *(const PG8_LAS bf16x8*)(lds + PG8_SA(b, h) + aoff + m * 2048 + k * 1024); } while (0)
#define PG8_LDB(dst, b, h) do { _Pragma("unroll") for (int n = 0; n < 2; ++n) _Pragma("unroll") for (int k = 0; k < 2; ++k) dst[n][k] = *(const PG8_LAS bf16x8*)(lds + PG8_SB(b, h) + boff + n * 2048 + k * 1024); } while (0)
#define PG8_MMA(ai, bj, At, Bt) do { __builtin_amdgcn_s_setprio(1); _Pragma("unroll") for (int m = 0; m < 4; ++m) _Pragma("unroll") for (int n = 0; n < 2; ++n) _Pragma("unroll") for (int k = 0; k < 2; ++k) \
        acc[ai][bj][m][n] = __builtin_amdgcn_mfma_f32_16x16x32_bf16(Bt[n][k], At[m][k], acc[ai][bj][m][n], 0, 0, 0); __builtin_amdgcn_s_setprio(0); } while (0)
#define PG8_WAIT_V(n) asm volatile("s_waitcnt vmcnt(" #n ")" ::: "memory")
#define PG8_WAIT_L(n) asm volatile("s_waitcnt lgkmcnt(" #n ")" ::: "memory")
#define PG8_BAR __builtin_amdgcn_s_barrier()
#define PG8_SCHED __builtin_amdgcn_sched_barrier(0)
    Unit cur, nxt; int ui = 0;
    if (!S.next(0, cur)) return;
    f32x4 acc[2][2][4][2];
#pragma unroll
    for (int a = 0; a < 2; ++a)
#pragma unroll
        for (int b = 0; b < 2; ++b)
#pragma unroll
            for (int m = 0; m < 4; ++m)
#pragma unroll
                for (int n = 0; n < 2; ++n) acc[a][b][m][n] = (f32x4){0.f, 0.f, 0.f, 0.f};
    bf16x8 At[4][2], B0[2][2], B1[2][2];
    const char* cA = (const char*)g.A + (size_t)cur.pm * tstep; const char* cB = (const char*)g.Bt + (size_t)cur.pn * tstep;
    S.a_ready(cur);
    if constexpr (SP2) {
        PG8_STAGE(PG8_SB(0, 0), cB, voffB); PG8_STAGE(PG8_SB(0, 1), cB + hstep, voffB); PG8_STAGE(PG8_SA(0, 0), cA, voffA); PG8_STAGE(PG8_SA(0, 1), cA + hstep, voffA);
        if (wr == 1) PG8_BAR;
        PG8_WAIT_V(2); PG8_BAR;
        PG8_STAGE(PG8_SB(1, 0), cB + kstep, voffB); PG8_STAGE(PG8_SA(1, 0), cA + kstep, voffA); PG8_STAGE(PG8_SB(1, 1), cB + hstep + kstep, voffB);
        PG8_WAIT_V(6); PG8_BAR;
    } else {
        PG8_STAGE(PG8_SB(0, 0), cB, voffB); PG8_STAGE(PG8_SA(0, 0), cA, voffA); PG8_STAGE(PG8_SB(0, 1), cB + hstep, voffB); PG8_STAGE(PG8_SA(0, 1), cA + hstep, voffA);
        if (wr == 1) PG8_BAR;
        PG8_WAIT_V(4); PG8_BAR;
        PG8_STAGE(PG8_SB(1, 0), cB + kstep, voffB); PG8_STAGE(PG8_SA(1, 0), cA + kstep, voffA); PG8_STAGE(PG8_SB(1, 1), cB + hstep + kstep, voffB);
        PG8_WAIT_V(6); PG8_BAR;
    }
    for (;;) {
        const bool has_next = S.next(ui + 1, nxt);
        const char* nA = has_next ? (const char*)g.A + (size_t)nxt.pm * tstep : cA; const char* nB = has_next ? (const char*)g.Bt + (size_t)nxt.pn * tstep : cB;
        for (int t = 0; t < nt; t += 2) {
            const bool last = (t == nt - 2);
            const char* a1 = cA + (size_t)(t + 1) * kstep;
            const char* a2 = last ? nA : cA + (size_t)(t + 2) * kstep; const char* b2 = last ? nB : cB + (size_t)(t + 2) * kstep;
            const char* a3 = a2 + kstep; const char* b3 = b2 + kstep;
            if (last && has_next) S.a_ready(nxt);
            if constexpr (SP2) {
            PG8_LDB(B0, 0, 0); PG8_LDB(B1, 0, 1); PG8_SCHED; PG8_LDA(At, 0, 0); PG8_STAGE(PG8_SA(1, 1), a1 + hstep, voffA);
            PG8_WAIT_V(8); PG8_WAIT_L(0); PG8_BAR; PG8_MMA(0, 0, At, B0); PG8_MMA(0, 1, At, B1); PG8_BAR; PG8_SCHED;
            PG8_LDA(At, 0, 1); PG8_STAGE(PG8_SB(0, 0), b2, voffB); PG8_STAGE(PG8_SB(0, 1), b2 + hstep, voffB); PG8_STAGE(PG8_SA(0, 0), a2, voffA);
            PG8_WAIT_V(8); PG8_WAIT_L(0); PG8_BAR; PG8_MMA(1, 0, At, B0); PG8_MMA(1, 1, At, B1); PG8_BAR; PG8_SCHED;
            PG8_LDB(B0, 1, 0); PG8_LDB(B1, 1, 1); PG8_SCHED; PG8_LDA(At, 1, 0); PG8_STAGE(PG8_SA(0, 1), a2 + hstep, voffA);
            PG8_WAIT_V(8); PG8_WAIT_L(0); PG8_BAR; PG8_MMA(0, 0, At, B0); PG8_MMA(0, 1, At, B1); PG8_BAR; PG8_SCHED;
            PG8_LDA(At, 1, 1); PG8_STAGE(PG8_SB(1, 0), b3, voffB); PG8_STAGE(PG8_SB(1, 1), b3 + hstep, voffB); PG8_STAGE(PG8_SA(1, 0), a3, voffA);
            PG8_WAIT_V(8); PG8_WAIT_L(0); PG8_BAR; PG8_MMA(1, 0, At, B0); PG8_MMA(1, 1, At, B1); PG8_BAR; PG8_SCHED;
            } else {
            PG8_LDB(B0, 0, 0); PG8_SCHED; PG8_LDA(At, 0, 0); PG8_STAGE(PG8_SA(1, 1), a1 + hstep, voffA);
            PG8_WAIT_L(8); PG8_BAR; PG8_WAIT_L(0); PG8_MMA(0, 0, At, B0); PG8_BAR; PG8_SCHED;
            PG8_LDB(B1, 0, 1); PG8_STAGE(PG8_SB(0, 0), b2, voffB);
            PG8_BAR; PG8_WAIT_L(0); PG8_MMA(0, 1, At, B1); PG8_BAR;
            PG8_LDA(At, 0, 1); PG8_STAGE(PG8_SA(0, 0), a2, voffA);
            PG8_BAR; PG8_WAIT_L(0); PG8_MMA(1, 0, At, B0); PG8_BAR; PG8_SCHED;
            PG8_STAGE(PG8_SB(0, 1), b2 + hstep, voffB);
            PG8_WAIT_V(6); PG8_BAR; PG8_MMA(1, 1, At, B1); PG8_BAR;
            PG8_LDB(B0, 1, 0); PG8_SCHED; PG8_LDA(At, 1, 0); PG8_STAGE(PG8_SA(0, 1), a2 + hstep, voffA);
            PG8_WAIT_L(8); PG8_BAR; PG8_WAIT_L(0); PG8_MMA(0, 0, At, B0); PG8_BAR; PG8_SCHED;
            PG8_LDB(B1, 1, 1); PG8_STAGE(PG8_SB(1, 0), b3, voffB);
            PG8_BAR; PG8_WAIT_L(0); PG8_MMA(0, 1, At, B1); PG8_BAR;
            PG8_LDA(At, 1, 1); PG8_STAGE(PG8_SA(1, 0), a3, voffA);
            PG8_BAR; PG8_WAIT_L(0); PG8_MMA(1, 0, At, B0); PG8_BAR; PG8_SCHED;
            PG8_STAGE(PG8_SB(1, 1), b3 + hstep, voffB);
            PG8_WAIT_V(6); PG8_BAR; PG8_MMA(1, 1, At, B1); PG8_BAR;
            }
        }
        if constexpr (ALIGN_EPI) { if (wr == 0) PG8_BAR; }
        if constexpr (!Epi::AFTER_DRAIN) { E(acc, cur, wr, wc, fr, fq); S.done(cur); }
        if (!has_next) break;
#pragma unroll
        for (int a = 0; a < 2; ++a)
#pragma unroll
            for (int b = 0; b < 2; ++b)
#pragma unroll
                for (int m = 0; m < 4; ++m)
#pragma unroll
                    for (int n = 0; n < 2; ++n) acc[a][b][m][n] = (f32x4){0.f, 0.f, 0.f, 0.f};
        cur = nxt; cA = nA; cB = nB; ++ui;
        if constexpr (ALIGN_EPI) { if (wr == 1) PG8_BAR; }
    }
    PG8_WAIT_V(0);
    if constexpr (!ALIGN_EPI) { if (wr == 0) PG8_BAR; }
    PG8_BAR;
    if constexpr (Epi::AFTER_DRAIN) { E.fused(acc, cur, wr, wc, fr, fq, lds, wid, lane); S.done(cur); }
#undef PG8_SA
#undef PG8_SB
#undef PG8_STAGE
#undef PG8_LDA
#undef PG8_LDB
#undef PG8_MMA
#undef PG8_WAIT_V
#undef PG8_WAIT_L
#undef PG8_BAR
#undef PG8_SCHED
}
}
#define LAS __attribute__((address_space(3)))
#define XB_TMO      128
#define XB_XCNT(j)  (256  + 64 * (j))
#define XB_XSUB(j)  (1280 + 64 * (j))
#define XB_XGEN(j)  (2304 + 64 * (j))
#define XB_TOP      3328
#define XB_TOPGEN   3392
#define XCD_BAR_WORDS 3456
#define XB_SPIN_CAP (1u << 18)

__device__ __forceinline__ unsigned xb_ld(unsigned* p)              { return __hip_atomic_load(p, __ATOMIC_RELAXED, __HIP_MEMORY_SCOPE_AGENT); }
__device__ __forceinline__ unsigned xb_add(unsigned* p, unsigned v) { return __hip_atomic_fetch_add(p, v, __ATOMIC_RELAXED, __HIP_MEMORY_SCOPE_AGENT); }
__device__ __forceinline__ unsigned xb_xcc_id() { return (unsigned)__builtin_amdgcn_s_getreg((3 << 11) | 20) & 0xFu; }
#define XB_SPIN(cond, bar) do { unsigned _sp = 0; while (cond) { __builtin_amdgcn_s_sleep(1); \
    if ((++_sp & 255u) == 0u) { if (xb_ld(&(bar)[XB_TMO])) break; if (_sp > XB_SPIN_CAP) { atomicAdd(&(bar)[XB_TMO], 1u); break; } } } } while (0)

struct XcdBarrier {
    unsigned* bar; unsigned x;
    volatile LAS unsigned* st;
};

__device__ __forceinline__ XcdBarrier xcd_barrier_post(unsigned* bar, volatile LAS unsigned* st) {
    XcdBarrier b; b.bar = bar; b.x = xb_xcc_id(); b.st = st;
    if (threadIdx.x == 0) (void)xb_add(&bar[XB_XCNT(b.x)], 1u);
    return b;
}
__device__ __forceinline__ void xcd_barrier_complete(unsigned* bar, unsigned x, unsigned& nloc, unsigned& nx) {
    const unsigned G = gridDim.x * gridDim.y * gridDim.z;
    unsigned sum, cnt, mine, sp = 0u;
    for (;;) {
        sum = 0u; cnt = 0u; mine = 0u;
#pragma unroll
        for (unsigned j = 0; j < 16; ++j) { const unsigned c = xb_ld(&bar[XB_XCNT(j)]); sum += c; cnt += (c > 0u) ? 1u : 0u; mine = (j == x) ? c : mine; }
        if (sum == G) break;
        __builtin_amdgcn_s_sleep(1);
        if ((++sp & 255u) == 0u) { if (xb_ld(&bar[XB_TMO])) break; if (sp > XB_SPIN_CAP) { atomicAdd(&bar[XB_TMO], 1u); break; } }
    }
    nloc = mine > 0u ? mine : 1u; nx = cnt > 0u ? cnt : 1u;
}

__device__ __forceinline__ void xcd_barrier(const XcdBarrier& b) {
    asm volatile("s_waitcnt vmcnt(0)" ::: "memory");
    __syncthreads();
    if (threadIdx.x == 0) {
        unsigned* bar = b.bar;
        __builtin_amdgcn_s_waitcnt(0);
        unsigned nloc = b.st[0], nx = b.st[1];
        if (nloc == 0u) { xcd_barrier_complete(bar, b.x, nloc, nx); b.st[0] = nloc; b.st[1] = nx; }
        const unsigned old = xb_add(&bar[XB_XSUB(b.x)], 1u);
        const unsigned gen = old / nloc;
        if (old + 1u == (gen + 1u) * nloc) {
            __builtin_amdgcn_fence(__ATOMIC_RELEASE, "agent");
            asm volatile("s_waitcnt vmcnt(0)" ::: "memory");
            const unsigned og = xb_add(&bar[XB_TOP], 1u);
            const unsigned tg = og / nx;
            if (og + 1u == (tg + 1u) * nx) xb_add(&bar[XB_TOPGEN], 1u);
            else XB_SPIN(xb_ld(&bar[XB_TOPGEN]) == tg, bar);
            __builtin_amdgcn_fence(__ATOMIC_ACQUIRE, "agent");
            xb_add(&bar[XB_XGEN(b.x)], 1u);
            asm volatile("s_waitcnt vmcnt(0)" ::: "memory");
        } else {
            XB_SPIN(xb_ld(&bar[XB_XGEN(b.x)]) == gen, bar);
            __builtin_amdgcn_fence(__ATOMIC_ACQUIRE, "agent");
            asm volatile("s_waitcnt vmcnt(0)" ::: "memory");
        }
    }
    __syncthreads();
}

#define GAS __attribute__((address_space(1)))
#define LAS __attribute__((address_space(3)))
typedef unsigned short bf16;
typedef unsigned v4u __attribute__((ext_vector_type(4)));
typedef unsigned v2u __attribute__((ext_vector_type(2)));
typedef float f32x4 __attribute__((ext_vector_type(4)));
typedef float f32x16 __attribute__((ext_vector_type(16)));
typedef short bf16x8 __attribute__((ext_vector_type(8)));
typedef short s16x4 __attribute__((ext_vector_type(4)));
#if MK_DIAG_F32
typedef float act_t;
#else
typedef bf16 act_t;
#endif

constexpr int DM = 1024, TP = 2048, NPB = 8, NP = NPB * TP, NSB = 32, TS = 4, NS = NSB * TS, NR = NP + NS, NSEQ = NPB + NSB;
constexpr int AW = 512, INP = 4608, DFF = 2816, UPC = 5632, MODC = 6144;
constexpr int NWV = 8, NTHR = 512, NRP = NP + 256;
constexpr float EPS = 1e-6f;
constexpr float LOG2E = 1.4426950408889634f;
constexpr float QSCALE = 0.125f * LOG2E;
constexpr float NEGBIG = -1e30f;
constexpr size_t O_YP = 0, O_YS = 16777216, O_KVP = 16908288, O_KVS = 25296896, O_WINP = 25362432, O_WINS = 26411008, O_VCH = 30605312, O_CONVP = 30670848, O_CONVS = 30760960, O_END = 31121408;

constexpr size_t al4k(size_t x) { return (x + 4095) & ~(size_t)4095; }
constexpr size_t ASZ = sizeof(act_t);
constexpr size_t WS_CTL = 0, CTL_ZERO_BYTES = 1u << 20;
constexpr size_t WS_MOD = WS_CTL + CTL_ZERO_BYTES;
constexpr size_t WS_B1P = WS_MOD + al4k((size_t)NSEQ * MODC * 4);
constexpr size_t WS_W1F = WS_B1P + 4096;
constexpr size_t WS_W1L = WS_W1F + al4k((size_t)2 * 4096 * 64 * 2);
constexpr size_t WS_WSB = WS_W1L + al4k((size_t)2 * 4096 * 64 * 2);
constexpr size_t WS_QS = WS_WSB + al4k((size_t)4 * 128 * 128 * 2) - al4k((size_t)2 * 4096 * 64 * 2) + al4k((size_t)2 * 4096 * 64 * 2);
constexpr size_t WS_WIN = WS_QS + al4k((size_t)NS * 512 * 4);
constexpr size_t WS_WA = WS_WIN + al4k((size_t)INP * DM * 2);
constexpr size_t WS_WB = WS_WA + al4k((size_t)DM * AW * 2);
constexpr size_t WS_WOUT = WS_WB + al4k((size_t)DM * AW * 2);
constexpr size_t WS_WUP = WS_WOUT + al4k((size_t)DM * DM * 2);
constexpr size_t WS_WDN = WS_WUP + al4k((size_t)UPC * DM * 2);
constexpr size_t WS_KCP = WS_WDN + al4k((size_t)DM * DFF * 2);
constexpr size_t WS_VCP = WS_KCP + al4k((size_t)NPB * 32 * 128 * 4);
constexpr size_t WS_KCS = WS_VCP + al4k((size_t)NPB * 32 * 128 * 4);
constexpr size_t WS_VCS = WS_KCS + al4k((size_t)NSB * 256 * 128 * 4);
constexpr size_t WS_HN = WS_VCS + al4k((size_t)NSB * 256 * 128 * 4);
constexpr size_t WS_U = WS_HN + al4k((size_t)NRP * DM * ASZ);
constexpr size_t WS_V = WS_U + al4k((size_t)NR * AW * ASZ);
constexpr size_t WS_Q = WS_V + al4k((size_t)NR * AW * 4);
constexpr size_t WS_KVSB = WS_Q + al4k((size_t)NR * 512 * 2);
constexpr size_t WS_KVWB = WS_KVSB + al4k((size_t)NR * 256 * 2);
constexpr size_t WS_ZG = WS_KVWB + al4k((size_t)NR * 256 * 2);
constexpr size_t WS_GAB = WS_ZG + al4k((size_t)NR * 32 * 4);
constexpr size_t WS_YA = WS_GAB + al4k((size_t)NR * 2048 * ASZ);
constexpr size_t WS_YB = WS_YA + al4k((size_t)NR * 512 * ASZ);
constexpr size_t WS_MIXF = WS_YB + al4k((size_t)NR * 512 * ASZ);
constexpr size_t WS_MIX = WS_MIXF + al4k((size_t)NR * DM * 4);
constexpr size_t WS_X1 = WS_MIX + al4k((size_t)NR * DM * ASZ);
constexpr size_t WS_H2 = WS_X1 + al4k((size_t)NR * DM * 4);
constexpr size_t WS_UP = WS_H2 + al4k((size_t)NRP * DM * ASZ);
constexpr size_t WS_ACT = WS_UP + al4k((size_t)NR * UPC * ASZ);
constexpr size_t WS_X2 = WS_ACT + al4k((size_t)NR * DFF * ASZ);
constexpr size_t WS_UPS = WS_X2 + al4k((size_t)NR * DM * 4);
constexpr size_t WS_TAIL = WS_UPS + al4k((size_t)NS * UPC * 4);
constexpr size_t WS_HEAD = WS_TAIL + al4k((size_t)65 * 2 * UPC * 4);
constexpr size_t WS_PRE = WS_HEAD + al4k((size_t)65 * 2 * UPC * 4);
constexpr size_t WS_QF = WS_PRE + al4k((size_t)16 * 4 * 4096 * 4) - al4k((size_t)65 * 2 * UPC * 4) + WS_HEAD - WS_HEAD + al4k((size_t)65 * 2 * UPC * 4) - al4k((size_t)NR * DM * 4) + al4k((size_t)NR * DM * 4);
constexpr size_t WS_KVWF = WS_QF + (MK_DIAG_F32 ? al4k((size_t)NP * 512 * 4) : 0);
constexpr size_t WS_END = WS_KVWF + (MK_DIAG_F32 ? al4k((size_t)NP * 256 * 4) : 0);
constexpr int CW_BAR = 4096, CW_CMP = 8192;

constexpr int RING_BYTES = 131072, MISC_OFF = RING_BYTES + 320, LDS_BYTES = 147456;

__device__ __forceinline__ float ex2(float x) { return __builtin_amdgcn_exp2f(x); }
__device__ __forceinline__ float rcpf_(float x) { return __builtin_amdgcn_rcpf(x); }
__device__ __forceinline__ float sigmoidf_(float x) { return rcpf_(1.0f + ex2(-LOG2E * x)); }
__device__ __forceinline__ float gelu_t(float x) { const float u = x + 0.044715f * x * x * x; return x * rcpf_(1.0f + ex2(-2.3022081985f * u)); }
__device__ __forceinline__ unsigned pk2(float lo, float hi) { return pg8::cvt_pk_bf16(lo, hi); }
__device__ __forceinline__ bf16 f2bf(float f) { return (bf16)(pk2(f, 0.f) & 0xffffu); }
__device__ __forceinline__ float bf2f(bf16 b) { return __builtin_bit_cast(float, (unsigned)b << 16); }
__device__ __forceinline__ void st8_bf(bf16* p, const float* v) { v4u w; w.x = pk2(v[0], v[1]); w.y = pk2(v[2], v[3]); w.z = pk2(v[4], v[5]); w.w = pk2(v[6], v[7]); *(v4u*)p = w; }
__device__ __forceinline__ void st8_f32(float* p, const float* v) { *(f32x4*)p = (f32x4){v[0], v[1], v[2], v[3]}; *(f32x4*)(p + 4) = (f32x4){v[4], v[5], v[6], v[7]}; }
__device__ __forceinline__ void ld8_f32(const float* p, float* v) { const f32x4 a = *(const f32x4*)p, b = *(const f32x4*)(p + 4); v[0] = a[0]; v[1] = a[1]; v[2] = a[2]; v[3] = a[3]; v[4] = b[0]; v[5] = b[1]; v[6] = b[2]; v[7] = b[3]; }
__device__ __forceinline__ void ld8_bf(const bf16* p, float* v) { const v4u w = *(const v4u*)p;
    v[0] = __builtin_bit_cast(float, w.x << 16); v[1] = __builtin_bit_cast(float, w.x & 0xffff0000u); v[2] = __builtin_bit_cast(float, w.y << 16); v[3] = __builtin_bit_cast(float, w.y & 0xffff0000u);
    v[4] = __builtin_bit_cast(float, w.z << 16); v[5] = __builtin_bit_cast(float, w.z & 0xffff0000u); v[6] = __builtin_bit_cast(float, w.w << 16); v[7] = __builtin_bit_cast(float, w.w & 0xffff0000u); }
#if MK_DIAG_F32
__device__ __forceinline__ void st8_act(act_t* p, const float* v) { st8_f32(p, v); }
__device__ __forceinline__ void ld8_act(const act_t* p, float* v) { ld8_f32(p, v); }
__device__ __forceinline__ float ld_act(const act_t* p) { return *p; }
__device__ __forceinline__ void st_act(act_t* p, float v) { *p = v; }
#else
__device__ __forceinline__ void st8_act(act_t* p, const float* v) { st8_bf(p, v); }
__device__ __forceinline__ void ld8_act(const act_t* p, float* v) { ld8_bf(p, v); }
__device__ __forceinline__ float ld_act(const act_t* p) { return bf2f(*p); }
__device__ __forceinline__ void st_act(act_t* p, float v) { *p = f2bf(v); }
#endif
__device__ __forceinline__ float wave_sum(float v) {
#pragma unroll
    for (int o = 1; o < 64; o <<= 1) v += __shfl_xor(v, o);
    return v;
}
__device__ __forceinline__ float wave_max(float v) {
#pragma unroll
    for (int o = 1; o < 64; o <<= 1) v = fmaxf(v, __shfl_xor(v, o));
    return v;
}
__device__ __forceinline__ int crow(int r, int hi) { return (r & 3) + 8 * (r >> 2) + 4 * hi; }
__device__ __forceinline__ bf16x8 pack8(const f32x4 a, const f32x4 b) { v4u w; w.x = pk2(a[0], a[1]); w.y = pk2(a[2], a[3]); w.z = pk2(b[0], b[1]); w.w = pk2(b[2], b[3]); return __builtin_bit_cast(bf16x8, w); }
#define LDS_WAIT() asm volatile("s_waitcnt lgkmcnt(0)" ::: "memory")

struct Args { const void* in[30]; float* out; unsigned char* ws; int ph_lo, ph_hi, li, pad; };
struct Frame {
    LAS unsigned char* lds; int tid, lane, wave, G, bid;
    const float *x_p, *x_s, *cache, *st_win, *st_conv; const int* ptab; const float *c_p, *c_s, *w_ada, *b_ada, *g1, *w_in, *lng, *lnb, *w_sp, *b_sp, *pe, *cw1, *cb1, *cw2, *cb2, *w_a, *w_b, *w_out, *g2, *w_up, *w_conv, *b_conv, *w_dn, *g_fin;
    float* out; unsigned char* ws;
    float *UPS, *TAIL, *HEAD, *PRE; float *MOD, *B1P, *KCP, *VCP, *KCS, *VCS, *V, *ZG, *MIXF, *X1, *X2;
    float* QS; float* QF; float* KVWF; bf16 *W1L; bf16* WSB; bf16 *W1F, *WIN, *WA, *WB, *WOUT, *WUP, *WDN, *Q, *KVSB, *KVWB;
    act_t *HN, *U, *GAB, *YA, *YB, *MIX, *H2, *UP, *ACT;
};
__device__ __forceinline__ int seq_of(int row) { return row < NP ? (row >> 11) : NPB + ((row - NP) >> 2); }
__device__ __forceinline__ const float* xrow_of(const Frame& F, int row) { return row < NP ? F.x_p + (size_t)row * DM : F.x_s + (size_t)(row - NP) * DM; }

struct MapId { __device__ __forceinline__ int operator()(int n) const { return n; } };
struct MapIn { __device__ __forceinline__ int operator()(int n) const { return n < 2304 ? n : (n < 4352 ? n + 24 : (n < 4376 ? n - 4352 + 2304 : -1)); } };

struct MapUp { __device__ __forceinline__ int operator()(int n) const { const int t = n >> 8, c = n & 255; return c < 128 ? 128 * t + c : DFF + 128 * t + (c - 128); } };

template <class Fn, class Map> __device__ __forceinline__ void gemm_naive(Frame& F, const float* A, const float* W, int ldw, Map map, int M, int N, int K, const Fn& f) {
    LAS float* As = (LAS float*)F.lds;
    LAS float* Bs = As + 16 * 132;
    const int tid = F.tid, tr = tid >> 4, tc = tid & 15;
    const int nM = (M + 127) / 128, nN = N / 128, nt = nM * nN;
    for (int tile = F.bid; tile < nt; tile += F.G) {
        const int m0 = (tile / nN) * 128, n0 = (tile % nN) * 128;
        float acc[4][8];
#pragma unroll
        for (int i = 0; i < 4; ++i)
#pragma unroll
            for (int j = 0; j < 8; ++j) acc[i][j] = 0.f;
        const int arow = m0 + (tid >> 2), ak = (tid & 3) * 4;
        const int bk = tid >> 5, bn = (tid & 31) * 4; const int oc = map(n0 + bn);
        for (int k0 = 0; k0 < K; k0 += 16) {
            f32x4 av = (f32x4){0.f, 0.f, 0.f, 0.f}; if (arow < M) av = *(const f32x4*)(A + (size_t)arow * K + k0 + ak);
            f32x4 bv = (f32x4){0.f, 0.f, 0.f, 0.f}; if (oc >= 0) { const float* wp = W + (size_t)(k0 + bk) * ldw + oc; bv = (f32x4){wp[0], wp[1], wp[2], wp[3]}; }
            __syncthreads();
#pragma unroll
            for (int e = 0; e < 4; ++e) As[(ak + e) * 132 + (tid >> 2)] = av[e];
            *(LAS f32x4*)(Bs + bk * 128 + bn) = bv;
            __syncthreads();
#pragma unroll
            for (int kk = 0; kk < 16; ++kk) {
                const f32x4 a4 = *(const LAS f32x4*)(As + kk * 132 + tr * 4);
                const f32x4 b0 = *(const LAS f32x4*)(Bs + kk * 128 + tc * 8), b1 = *(const LAS f32x4*)(Bs + kk * 128 + tc * 8 + 4);
#pragma unroll
                for (int i = 0; i < 4; ++i) {
#pragma unroll
                    for (int j = 0; j < 4; ++j) { acc[i][j] += a4[i] * b0[j]; acc[i][4 + j] += a4[i] * b1[j]; } }
            }
        }
#pragma unroll
        for (int i = 0; i < 4; ++i) { const int row = m0 + tr * 4 + i; if (row < M) f(row, n0 + tc * 8, acc[i]); }
    }
    __syncthreads();
}

template <class Fn> struct Epi8 {
    static constexpr bool PERM = true, AFTER_DRAIN = false; Fn f;
    __device__ __forceinline__ void operator()(const pg8::f32x4 (&acc)[2][2][4][2], const pg8::Unit& u, int wr, int wc, int fr, int fq) const {
#pragma unroll
        for (int ai = 0; ai < 2; ++ai)
#pragma unroll
            for (int m = 0; m < 4; ++m)
#pragma unroll
                for (int bj = 0; bj < 2; ++bj) {
                    const int row = u.pm * 256 + ai * 128 + wr * 64 + m * 16 + fr, col = u.pn * 256 + bj * 128 + wc * 32 + 8 * fq;
                    float v[8]; const pg8::f32x4 a = acc[ai][bj][m][0], b = acc[ai][bj][m][1];
                    v[0] = a[0]; v[1] = a[1]; v[2] = a[2]; v[3] = a[3]; v[4] = b[0]; v[5] = b[1]; v[6] = b[2]; v[7] = b[3];
                    if (row < NR) f(row, col, v); }
    }
};
template <class Fn> __device__ __forceinline__ void sample_gemm(Frame& F, const bf16* A, const bf16* Bt, int K, int nvalid, const Fn& f) {
    const int lane = F.lane, r32 = lane & 31, hi = lane >> 5;
    LAS float* stg = (LAS float*)F.lds + F.wave * (32 * 33);
    const int nu = (nvalid + 31) / 32, nks = K / 16;
    for (int u = (F.G - 1 - F.bid) + F.G * F.wave; u < nu; u += F.G * NWV) {
        const int n0 = 32 * u;
        f32x16 acc[4];
#pragma unroll
        for (int mb = 0; mb < 4; ++mb) acc[mb] = (f32x16){};
        const bf16* bp = Bt + (size_t)(n0 + r32) * K + 8 * hi; const bf16* ap = A + (size_t)r32 * K + 8 * hi;
#pragma unroll 4
        for (int ks = 0; ks < nks; ++ks) {
            const bf16x8 b = *(const bf16x8*)(bp + 16 * ks);
#pragma unroll
            for (int mb = 0; mb < 4; ++mb) { const bf16x8 a = *(const bf16x8*)(ap + (size_t)(32 * mb) * K + 16 * ks); acc[mb] = __builtin_amdgcn_mfma_f32_32x32x16_bf16(a, b, acc[mb], 0, 0, 0); }
        }
#pragma unroll
        for (int mb = 0; mb < 4; ++mb) {
#pragma unroll
            for (int r = 0; r < 16; ++r) stg[crow(r, hi) * 33 + r32] = acc[mb][r];
            LDS_WAIT();
#pragma unroll
            for (int it = 0; it < 2; ++it) { const int m = (lane >> 2) + 16 * it, c8 = (lane & 3) * 8; float v[8];
#pragma unroll
                for (int e = 0; e < 8; ++e) v[e] = stg[m * 33 + c8 + e];
                if (n0 + c8 < nvalid) f(NP + 32 * mb + m, n0 + c8, v); }
            LDS_WAIT();
        }
    }
    __syncthreads();
}
template <bool FOLD, class Fn, class Map> __device__ __forceinline__ void run_gemm(Frame& F, const act_t* A, const float* W, int ldw, Map map, const bf16* Bt, int N, int K, int nvalid, const Fn& f) {
#if MK_DIAG_F32
    gemm_naive(F, A, W, ldw, map, NR, N, K, f);
#else
    { pg8::Gemm g{A, Bt, FOLD ? NRP : NP, N, K}; pg8::StaticOrder S; S.init(FOLD ? NRP : NP, N, F.G, F.bid); Epi8<Fn> E{f};
      pg8::gemm_phase<Epi8<Fn>, pg8::StaticOrder, true, true>(F.lds, g, S, E); }
    if (!FOLD) sample_gemm(F, A + (size_t)NP * K, Bt, K, nvalid, f);
#endif
}

struct EpiIn {
    unsigned char* ws; float* out;
    __device__ __forceinline__ void operator()(int row, int c0, const float* v) const {
        act_t* const U = (act_t*)(ws + WS_U); float* const V = (float*)(ws + WS_V); bf16* const Q = (bf16*)(ws + WS_Q); float* const QF = (float*)(ws + WS_QF); float* const KVWF = (float*)(ws + WS_KVWF); float* const QS = (float*)(ws + WS_QS);
        bf16* const KVSB = (bf16*)(ws + WS_KVSB); bf16* const KVWB = (bf16*)(ws + WS_KVWB); float* const ZG = (float*)(ws + WS_ZG); act_t* const GAB = (act_t*)(ws + WS_GAB);
        float o[8];
        if (c0 < 1024) {
#pragma unroll
            for (int e = 0; e < 8; ++e) o[e] = gelu_t(v[e]);
            if (c0 < 512) st8_act(U + (size_t)row * 512 + c0, o); else st8_f32(V + (size_t)row * 512 + (c0 - 512), o);
        } else if (c0 < 1536) {
#pragma unroll
            for (int e = 0; e < 8; ++e) o[e] = v[e] * QSCALE;
            if (row < NP) { st8_bf(Q + (size_t)row * 512 + (c0 - 1024), o); if (MK_DIAG_F32) st8_f32(QF + (size_t)row * 512 + (c0 - 1024), o); } else st8_f32(QS + (size_t)(row - NP) * 512 + (c0 - 1024), o);
        } else if (c0 < 2304) {
            const int j = c0 - 1536;
            if (j < 512) {
                float* op = (row < NP ? out + O_KVP + (size_t)row * 512 : out + O_KVS + (size_t)(row - NP) * 512) + j; st8_f32(op, v);
                if (j >= 256) st8_bf(KVSB + (size_t)row * 256 + (j - 256), v);
            } else {
                const int j2 = j - 512; st8_bf(KVWB + (size_t)row * 256 + j2, v); if (MK_DIAG_F32 && row < NP) st8_f32(KVWF + (size_t)row * 256 + j2, v);
                if (row < NP) { const int t = row & (TP - 1); if (t >= TP - 512) st8_f32(out + O_WINP + ((size_t)(row >> 11) * 512 + (t - (TP - 512))) * 256 + j2, v); }
                else { const int rs = row - NP; st8_f32(out + O_WINS + ((size_t)(rs >> 2) * 512 + 508 + (rs & 3)) * 256 + j2, v); }
            }
        } else if (c0 < 4352) {
#pragma unroll
            for (int e = 0; e < 8; ++e) o[e] = sigmoidf_(v[e]);
            st8_act(GAB + (size_t)row * 2048 + (c0 - 2304), o);
        } else if (c0 < 4376) {
#pragma unroll
            for (int e = 0; e < 8; ++e) o[e] = sigmoidf_(v[e]);
            st8_f32(ZG + (size_t)row * 32 + (c0 - 4352), o);
        }
    }
};
struct EpiBrA { float* MIXF; const act_t* GAB; __device__ __forceinline__ void operator()(int row, int c0, const float* v) const {
    float g[8], o[8]; ld8_act(GAB + (size_t)row * 2048 + c0, g);
#pragma unroll
    for (int e = 0; e < 8; ++e) o[e] = g[e] * v[e];
    st8_f32(MIXF + (size_t)row * DM + c0, o); } };
struct EpiBrB { const float* MIXF; const act_t* GAB; act_t* MIX; __device__ __forceinline__ void operator()(int row, int c0, const float* v) const {
    float g[8], a[8], o[8]; ld8_act(GAB + (size_t)row * 2048 + 1024 + c0, g); ld8_f32(MIXF + (size_t)row * DM + c0, a);
#pragma unroll
    for (int e = 0; e < 8; ++e) o[e] = a[e] + g[e] * v[e];
    st8_act(MIX + (size_t)row * DM + c0, o); } };
struct EpiRes {
    const float* xp; const float* xs; const float* MOD; int goff; float* Xo;
    __device__ __forceinline__ void operator()(int row, int c0, const float* v) const {
        const float* xr = (row < NP ? xp + (size_t)row * DM : xs + (size_t)(row - NP) * DM) + c0; float a[8], g[8], o[8]; ld8_f32(xr, a); ld8_f32(MOD + (size_t)seq_of(row) * MODC + goff + c0, g);
#pragma unroll
        for (int e = 0; e < 8; ++e) o[e] = a[e] + g[e] * v[e];
        st8_f32(Xo + (size_t)row * DM + c0, o); } };
struct EpiUp { act_t* UP; float* out; __device__ __forceinline__ void operator()(int row, int c0, const float* v) const {
    st8_act(UP + (size_t)row * UPC + c0, v);
    if (row < NP) { const int t = row & (TP - 1); if (t >= TP - 2) st8_f32(out + O_CONVP + ((size_t)(row >> 11) * 2 + (t - (TP - 2))) * UPC + c0, v); }
    else { const int rs = row - NP, t = rs & 3; if (t >= 2) st8_f32(out + O_CONVS + ((size_t)(rs >> 2) * 2 + (t - 2)) * UPC + c0, v); } } };


#if !MK_DIAG_F32
template <int CTRL> __device__ __forceinline__ float dppf(float x) { return __builtin_bit_cast(float, __builtin_amdgcn_update_dpp(0, __builtin_bit_cast(int, x), CTRL, 0xf, 0xf, false)); }
struct EpiUpConv {
    static constexpr bool PERM = true, AFTER_DRAIN = false;
    unsigned char* ws; float* out; const float* w_conv; const float* b_conv; LAS float* T;
    __device__ __forceinline__ void operator()(const pg8::f32x4 (&acc)[2][2][4][2], const pg8::Unit& u, int wr, int wc, int fr, int fq) const {
        act_t* const ACT = (act_t*)(ws + WS_ACT); float* const UPS = (float*)(ws + WS_UPS); float* const TAIL = (float*)(ws + WS_TAIL); float* const HEAD = (float*)(ws + WS_HEAD);
        const int jj = 32 * wc + 8 * fq, nc0 = u.pn * 256, j = 128 * u.pn + jj;
        if (u.pm == NP / 256) {
#pragma unroll
            for (int ai = 0; ai < 2; ++ai)
#pragma unroll
                for (int m = 0; m < 4; ++m) { const int row = ai * 128 + wr * 64 + m * 16 + fr; if (row < NS) {
#pragma unroll
                    for (int bj = 0; bj < 2; ++bj) { *(f32x4*)(UPS + (size_t)row * UPC + nc0 + bj * 128 + jj) = acc[ai][bj][m][0]; *(f32x4*)(UPS + (size_t)row * UPC + nc0 + bj * 128 + jj + 4) = acc[ai][bj][m][1]; } } }
            return;
        }
        if (fr >= 14) {
#pragma unroll
            for (int ai = 0; ai < 2; ++ai)
#pragma unroll
                for (int bj = 0; bj < 2; ++bj) { LAS float* tp = T + ((ai * 2 + wr) * 2 + (fr - 14)) * 256 + bj * 128 + jj; *(LAS f32x4*)tp = acc[ai][bj][3][0]; *(LAS f32x4*)(tp + 4) = acc[ai][bj][3][1]; }
            if (wr == 1) {
#pragma unroll
                for (int bj = 0; bj < 2; ++bj) { float* gp = TAIL + ((size_t)u.pm * 2 + (fr - 14)) * UPC + nc0 + bj * 128 + jj; *(f32x4*)gp = acc[1][bj][3][0]; *(f32x4*)(gp + 4) = acc[1][bj][3][1];
                    if ((u.pm & 7) == 7) { float* op = out + O_CONVP + ((size_t)(u.pm >> 3) * 2 + (fr - 14)) * UPC + bj * DFF + j; *(f32x4*)op = acc[1][bj][3][0]; *(f32x4*)(op + 4) = acc[1][bj][3][1]; } } }
        }
        if (fr < 2 && wr == 0) {
#pragma unroll
            for (int bj = 0; bj < 2; ++bj) { float* gp = HEAD + ((size_t)u.pm * 2 + fr) * UPC + nc0 + bj * 128 + jj; *(f32x4*)gp = acc[0][bj][0][0]; *(f32x4*)(gp + 4) = acc[0][bj][0][1]; } }
        asm volatile("s_waitcnt lgkmcnt(0)" ::: "memory"); __builtin_amdgcn_s_barrier(); asm volatile("" ::: "memory");
        const bool seq_start = (u.pm & 7) == 0;
#pragma unroll
        for (int nh = 0; nh < 2; ++nh) {
            asm volatile("" ::: "memory");
            const int jc = j + 4 * nh;
            const f32x4 w0a = *(const f32x4*)(w_conv + jc), w1a = *(const f32x4*)(w_conv + UPC + jc), w2a = *(const f32x4*)(w_conv + 2 * UPC + jc), ba = *(const f32x4*)(b_conv + jc);
            const f32x4 w0g = *(const f32x4*)(w_conv + DFF + jc), w1g = *(const f32x4*)(w_conv + UPC + DFF + jc), w2g = *(const f32x4*)(w_conv + 2 * UPC + DFF + jc), bg = *(const f32x4*)(b_conv + DFF + jc);
#pragma unroll
            for (int ai = 0; ai < 2; ++ai) {
                f32x4 p1a, p2a, p1g, p2g;
                if (ai == 0 && wr == 0) { p1a = (f32x4){0.f, 0.f, 0.f, 0.f}; p2a = p1a; p1g = p1a; p2g = p1a; }
                else { const int pai = wr == 1 ? ai : ai - 1, pwr = wr == 1 ? 0 : 1; const LAS float* t14 = T + ((pai * 2 + pwr) * 2 + 0) * 256 + jj + 4 * nh; const LAS float* t15 = t14 + 256;
                    const f32x4 a15 = *(const LAS f32x4*)t15, a14 = *(const LAS f32x4*)t14, g15 = *(const LAS f32x4*)(t15 + 128), g14 = *(const LAS f32x4*)(t14 + 128);
                    p1a = a15; p1g = g15; p2a = fr == 1 ? a15 : a14; p2g = fr == 1 ? g15 : g14; }
#pragma unroll
                for (int m = 0; m < 4; ++m) { float o[4];
#pragma unroll
                    for (int e = 0; e < 4; ++e) { const float a = acc[ai][0][m][nh][e], g = acc[ai][1][m][nh][e];
                        const float r1a = dppf<0x121>(a), r2a = dppf<0x122>(a), r1g = dppf<0x121>(g), r2g = dppf<0x122>(g);
                        const float u1a = fr >= 1 ? r1a : p1a[e], u2a = fr >= 2 ? r2a : p2a[e], u1g = fr >= 1 ? r1g : p1g[e], u2g = fr >= 2 ? r2g : p2g[e];
                        const float ca = ba[e] + w0a[e] * u2a + w1a[e] * u1a + w2a[e] * a, cg = bg[e] + w0g[e] * u2g + w1g[e] * u1g + w2g[e] * g;
                        o[e] = gelu_t(ca) * cg; p1a[e] = r1a; p2a[e] = r2a; p1g[e] = r1g; p2g[e] = r2g; }
                    const bool skip = ai == 0 && wr == 0 && m == 0 && fr < 2 && !seq_start;
                    if (!skip) { act_t* op = ACT + (size_t)(u.pm * 256 + ai * 128 + wr * 64 + m * 16 + fr) * DFF + jc;
#if MK_DIAG_F32
                        *(f32x4*)op = (f32x4){o[0], o[1], o[2], o[3]};
#else
                        v2u wv; wv.x = pk2(o[0], o[1]); wv.y = pk2(o[2], o[3]); *(v2u*)op = wv;
#endif
                    } }
            }
        }
    }
};
#endif

__device__ __forceinline__ void p0_mod(Frame& F) {
    const int col0 = 32 * F.bid, w = F.wave, lane = F.lane, col = lane & 31, kh = lane >> 5;
    LAS float* sc = (LAS float*)F.lds + w * (64 * 40);
    float acc[40];
#pragma unroll
    for (int s = 0; s < 40; ++s) acc[s] = 0.f;
    for (int half = 0; half < 2; ++half) {
        const int kbase = w * 128 + half * 64;
#pragma unroll 8
        for (int s = 0; s < 40; ++s) { const float* cp = s < NPB ? F.c_p + (size_t)s * DM : F.c_s + (size_t)(s - NPB) * DM; const float c = cp[kbase + lane]; sc[lane * 40 + s] = c * sigmoidf_(c); }
        LDS_WAIT();
        for (int i = 0; i < 32; ++i) { const int kk = 2 * i + kh; const float wv = F.w_ada[(size_t)(kbase + kk) * MODC + col0 + col];
#pragma unroll
            for (int s4 = 0; s4 < 10; ++s4) { const f32x4 c4 = *(const LAS f32x4*)(sc + kk * 40 + 4 * s4);
#pragma unroll
                for (int e = 0; e < 4; ++e) acc[4 * s4 + e] += wv * c4[e]; } }
        LDS_WAIT();
    }
    __syncthreads();
    LAS float* red = (LAS float*)F.lds;
#pragma unroll
    for (int s = 0; s < 40; ++s) red[(w * 40 + s) * 64 + lane] = acc[s];
    __syncthreads();
    for (int idx = F.tid; idx < 40 * 32; idx += NTHR) { const int s = idx >> 5, c = idx & 31; float t = F.b_ada[col0 + c];
        for (int ww = 0; ww < NWV; ++ww) t += red[(ww * 40 + s) * 64 + c] + red[(ww * 40 + s) * 64 + 32 + c];
        F.MOD[(size_t)s * MODC + col0 + c] = t; }
    __syncthreads();
}
template <class Map> __device__ __forceinline__ void p0_transpose_item(const float* W, int K, int ldw, Map map, bf16* WT, LAS float* scr, int item, int nblk, int lane) {
    const int kb = item / nblk, nb = item % nblk, k0 = 64 * kb, n0 = 32 * nb; const int oc = map(n0 + (lane & 31));
#pragma unroll 8
    for (int i = 0; i < 32; ++i) { const int kk = 2 * i + (lane >> 5); scr[kk * 33 + (lane & 31)] = oc >= 0 ? W[(size_t)(k0 + kk) * ldw + oc] : 0.f; }
    LDS_WAIT(); asm volatile("" ::: "memory");
    const int c = lane & 7;
#pragma unroll
    for (int j = 0; j < 4; ++j) { const int n = (lane >> 3) + 8 * j; const LAS float* s = scr + (8 * c) * 33 + n;
        v4u o; o.x = pk2(s[0 * 33], s[1 * 33]); o.y = pk2(s[2 * 33], s[3 * 33]); o.z = pk2(s[4 * 33], s[5 * 33]); o.w = pk2(s[6 * 33], s[7 * 33]);
        *(v4u*)(WT + (size_t)(n0 + n) * K + k0 + 8 * c) = o; }
    LDS_WAIT(); asm volatile("" ::: "memory");
}
__device__ __forceinline__ void p0_prologue(Frame& F) {
    if (F.bid < 192) p0_mod(F);
    if (F.bid == F.G - 1) {
        const int slot = F.tid >> 8, kp = (F.tid >> 6) & 3, hid = F.tid & 63; float s = 0.f;
        const float* pe = F.pe + (size_t)slot * 4096 + kp * 1024; const float* w1 = F.cw1 + ((size_t)slot * 4096 + kp * 1024) * 64 + hid;
        for (int k = 0; k < 1024; ++k) s += pe[k] * w1[(size_t)k * 64];
        LAS float* r = (LAS float*)F.lds; r[F.tid] = s; __syncthreads();
        if (F.tid < 128) { const int sl = F.tid >> 6, h = F.tid & 63; F.B1P[F.tid] = F.cb1[F.tid] + r[sl * 256 + h] + r[sl * 256 + 64 + h] + r[sl * 256 + 128 + h] + r[sl * 256 + 192 + h]; }
        __syncthreads();
    }
#if !MK_DIAG_F32
    {
        LAS float* scr = (LAS float*)F.lds + F.wave * (64 * 33);
        const int gw = F.bid * NWV + F.wave, NGW = F.G * NWV;
        constexpr int I_IN = (DM / 64) * (INP / 32), I_A = (AW / 64) * (DM / 32), I_O = (DM / 64) * (DM / 32), I_UP = (DM / 64) * (UPC / 32), I_DN = (DFF / 64) * (DM / 32);
        constexpr int NITEMS = I_IN + 2 * I_A + I_O + I_UP + I_DN;
        for (int it = gw; it < NITEMS; it += NGW) {
            int r = it;
            if (r < I_IN) { p0_transpose_item(F.w_in, DM, 4376, MapIn(), F.WIN, scr, r, INP / 32, F.lane); continue; } r -= I_IN;
            if (r < I_A) { p0_transpose_item(F.w_a, AW, DM, MapId(), F.WA, scr, r, DM / 32, F.lane); continue; } r -= I_A;
            if (r < I_A) { p0_transpose_item(F.w_b, AW, DM, MapId(), F.WB, scr, r, DM / 32, F.lane); continue; } r -= I_A;
            if (r < I_O) { p0_transpose_item(F.w_out, DM, DM, MapId(), F.WOUT, scr, r, DM / 32, F.lane); continue; } r -= I_O;
            if (r < I_UP) { p0_transpose_item(F.w_up, DM, UPC, MapUp(), F.WUP, scr, r, UPC / 32, F.lane); continue; } r -= I_UP;
            p0_transpose_item(F.w_dn, DFF, DM, MapId(), F.WDN, scr, r, DM / 32, F.lane);
        }
    }
#endif
    for (int idx = F.bid * NTHR + F.tid; idx < 4 * 128 * 128 / 8; idx += F.G * NTHR) { const int e0 = idx * 8, t = (e0 >> 7) & 127, s0 = e0 & 127; float v[8]; ld8_f32(F.w_sp + e0, v);
#pragma unroll
        for (int e = 0; e < 8; ++e) if (s0 + e > t) v[e] = 0.f;
        st8_bf(F.WSB + e0, v); }
    for (int idx = F.bid * NTHR + F.tid; idx < 65536; idx += F.G * NTHR) {
        const int lane = idx & 63, nb = (idx >> 6) & 1, ks = (idx >> 7) & 3, i = (idx >> 9) & 63, slot = idx >> 15;
        const float* src = F.cw1 + (((size_t)slot * 64 + i) * 64 + 16 * ks + 8 * (lane >> 5)) * 64 + 32 * nb + (lane & 31);
        float hv[8], lv[8];
#pragma unroll
        for (int e = 0; e < 8; ++e) { const float x = src[e * 64]; const float xh = bf2f(f2bf(x)); hv[e] = xh; lv[e] = x - xh; }
        st8_bf(F.W1F + (size_t)idx * 8, hv); st8_bf(F.W1L + (size_t)idx * 8, lv);
    }
}

template <bool MODU, int NRW, class OT> __device__ __forceinline__ void rms_rows(const float* const (&xr)[NRW], const float* g, const float* const (&shift)[NRW], const float* const (&scale)[NRW], OT* const (&orow)[NRW], int lane) {
    f32x4 v[NRW][4]; float ss[NRW];
#pragma unroll
    for (int r = 0; r < NRW; ++r) {
#pragma unroll
        for (int j = 0; j < 4; ++j) v[r][j] = *(const f32x4*)(xr[r] + 4 * lane + 256 * j); }
#pragma unroll
    for (int r = 0; r < NRW; ++r) { ss[r] = 0.f;
#pragma unroll
        for (int j = 0; j < 4; ++j) ss[r] += (v[r][j][0] * v[r][j][0] + v[r][j][1] * v[r][j][1]) + (v[r][j][2] * v[r][j][2] + v[r][j][3] * v[r][j][3]); }
#pragma unroll
    for (int o = 1; o < 64; o <<= 1) {
#pragma unroll
        for (int r = 0; r < NRW; ++r) ss[r] += __shfl_xor(ss[r], o); }
#pragma unroll
    for (int r = 0; r < NRW; ++r) { const float rr = 1.0f / sqrtf(ss[r] * (1.0f / DM) + EPS);
#pragma unroll
        for (int j = 0; j < 4; ++j) { const int c = 4 * lane + 256 * j; const f32x4 gv = *(const f32x4*)(g + c); f32x4 y = v[r][j] * rr * gv;
            if (MODU) { const f32x4 sc = *(const f32x4*)(scale[r] + c), sh = *(const f32x4*)(shift[r] + c); y = y * (sc + 1.0f) + sh; }
            if (sizeof(OT) == 4) *(f32x4*)((float*)orow[r] + c) = y; else { v2u w; w.x = pk2(y[0], y[1]); w.y = pk2(y[2], y[3]); *(v2u*)((bf16*)orow[r] + c) = w; } } }
}

template <int MB, int NPOS, bool PARTIAL, class BaseFn> __device__ __forceinline__ void compress_unit(Frame& F, const BaseFn& basefn, int pos0, float* KCo, float* VCo, float* pre, int kq, unsigned* cnt) {
    const int tid = F.tid, w = F.wave, lane = F.lane, r32 = lane & 31, hi = lane >> 5, slot = w >> 2, mb = (w >> 1) & 1, nb = w & 1;
    constexpr int ABUF = 2 * 64 * 72;
    LAS bf16* AH = (LAS bf16*)F.lds; LAS bf16* AL = AH + 2 * ABUF; LAS float* red = (LAS float*)(F.lds + 4 * ABUF * 2);
    const int nl = tid >> 4, q = tid & 15; const bool stg = nl < 16 * MB; const float* sp = basefn(stg ? nl : 0) + q * 4;
    f32x4 ar[4][4]; bf16x8 bh[3][4];
#define CMP_LOADA(i, R) do { _Pragma("unroll") for (int k = 0; k < 4; ++k) ar[R][k] = stg ? *(const f32x4*)(sp + (size_t)(pos0 + (i)) * 512 + 64 * k) : (f32x4){0.f, 0.f, 0.f, 0.f}; } while (0)
#define CMP_WRITEA(buf, R) do { if (stg) { _Pragma("unroll") for (int k = 0; k < 4; ++k) { const int idx = (buf) * ABUF + ((k >> 1) * 64 + nl * 2 + (k & 1)) * 72 + 4 * q; \
        const unsigned h0 = pk2(ar[R][k][0], ar[R][k][1]), h1 = pk2(ar[R][k][2], ar[R][k][3]); \
        const float r0 = ar[R][k][0] - __builtin_bit_cast(float, h0 << 16), r1 = ar[R][k][1] - __builtin_bit_cast(float, h0 & 0xffff0000u), r2 = ar[R][k][2] - __builtin_bit_cast(float, h1 << 16), r3 = ar[R][k][3] - __builtin_bit_cast(float, h1 & 0xffff0000u); \
        v2u hv; hv.x = h0; hv.y = h1; *(LAS v2u*)(AH + idx) = hv; v2u lv; lv.x = pk2(r0, r1); lv.y = pk2(r2, r3); *(LAS v2u*)(AL + idx) = lv; } } } while (0)
#define CMP_LOADB(i, R) do { _Pragma("unroll") for (int ks = 0; ks < 4; ++ks) { const size_t bo = ((((size_t)slot * 64 + pos0 + (i)) * 4 + ks) * 2 + nb) * 512 + lane * 8; bh[R][ks] = *(const bf16x8*)(F.W1F + bo); } } while (0)
#define CMP_STEP(i, RA, RB) do { \
        if ((i) + 2 < NPOS) CMP_LOADB((i) + 2, ((RB) + 2) % 3); \
        if ((i) + 4 < NPOS) CMP_LOADA((i) + 4, RA); \
        if (mb < MB) { const LAS bf16* ah = AH + ((i) & 1) * ABUF + (slot * 64 + 32 * mb + r32) * 72 + 8 * hi; const LAS bf16* al = AL + ((i) & 1) * ABUF + (slot * 64 + 32 * mb + r32) * 72 + 8 * hi; \
            _Pragma("unroll") for (int ks = 0; ks < 4; ++ks) { const bf16x8 a = *(const LAS bf16x8*)(ah + 16 * ks), a2 = *(const LAS bf16x8*)(al + 16 * ks); \
                acc = __builtin_amdgcn_mfma_f32_32x32x16_bf16(a, bh[RB][ks], acc, 0, 0, 0); acc = __builtin_amdgcn_mfma_f32_32x32x16_bf16(a2, bh[RB][ks], acc, 0, 0, 0); } } \
        if ((i) + 1 < NPOS) CMP_WRITEA(((i) + 1) & 1, ((RA) + 1) & 3); \
        __syncthreads(); } while (0)
    f32x16 acc = (f32x16){};
    CMP_LOADB(0, 0); CMP_LOADA(0, 0); CMP_LOADB(1, 1); CMP_LOADA(1, 1); CMP_LOADA(2, 2); CMP_LOADA(3, 3); CMP_WRITEA(0, 0);
    __syncthreads();
    static_assert((NPOS - 4) % 12 == 0, "compress_unit: NPOS = 12 k + 4");
    for (int i = 0; i < NPOS - 4; i += 12) { CMP_STEP(i, 0, 0); CMP_STEP(i + 1, 1, 1); CMP_STEP(i + 2, 2, 2); CMP_STEP(i + 3, 3, 0); CMP_STEP(i + 4, 0, 1); CMP_STEP(i + 5, 1, 2);
                                             CMP_STEP(i + 6, 2, 0); CMP_STEP(i + 7, 3, 1); CMP_STEP(i + 8, 0, 2); CMP_STEP(i + 9, 1, 0); CMP_STEP(i + 10, 2, 1); CMP_STEP(i + 11, 3, 2); }
    CMP_STEP(NPOS - 4, 0, 0); CMP_STEP(NPOS - 3, 1, 1); CMP_STEP(NPOS - 2, 2, 2); CMP_STEP(NPOS - 1, 3, 0);
#undef CMP_STEP
#undef CMP_LOADA
#undef CMP_WRITEA
#undef CMP_LOADB
    if (PARTIAL) {
        static_assert(!PARTIAL || MB == 1, "partial mode: 32 rows per slot");
        if (mb < MB) {
#pragma unroll
            for (int r = 0; r < 16; ++r) __hip_atomic_store(pre + (size_t)kq * 4096 + (slot * 32 + crow(r, hi)) * 64 + 32 * nb + r32, acc[r], __ATOMIC_RELAXED, __HIP_MEMORY_SCOPE_AGENT); }
        asm volatile("s_waitcnt vmcnt(0)" ::: "memory");
        __syncthreads();
        LAS unsigned* flag = (LAS unsigned*)(F.lds + RING_BYTES + 512);
        if (F.tid == 0) *flag = __hip_atomic_fetch_add(cnt, 1u, __ATOMIC_RELAXED, __HIP_MEMORY_SCOPE_AGENT);
        __syncthreads();
        const bool last = *flag == 3u;
        __syncthreads();
        if (!last) return;
        __builtin_amdgcn_fence(__ATOMIC_ACQUIRE, "agent"); asm volatile("s_waitcnt vmcnt(0)" ::: "memory");
        for (int e = F.tid; e < 4096; e += NTHR) { const int sl = e >> 11, m = (e >> 6) & 31, hid = e & 63; const float sum = (pre[e] + pre[4096 + e]) + (pre[8192 + e] + pre[12288 + e]);
            red[(sl * 64 + m) * 64 + hid] = gelu_t(sum + F.B1P[sl * 64 + hid]); }
        __syncthreads();
    } else {
    if (mb < MB) {
#pragma unroll
        for (int r = 0; r < 16; ++r) red[(slot * 64 + 32 * mb + crow(r, hi)) * 64 + 32 * nb + r32] = acc[r]; }
    __syncthreads();
    for (int e = F.tid; e < 8192; e += NTHR) if (((e >> 6) & 63) < 32 * MB) red[e] = gelu_t(red[e] + F.B1P[(e >> 12) * 64 + (e & 63)]);
    __syncthreads();
    }
    { const int e = F.tid & 63, grp = F.tid >> 6;
      for (int it = 0; it < 16; ++it) { const int sm = it * 8 + grp, sl = sm >> 6, m = sm & 63; if (m >= 32 * MB) continue; float s = F.cb2[sl * 64 + e];
          const float* w2 = F.cw2 + (size_t)sl * 4096 + e; const LAS float* hp = red + sm * 64;
#pragma unroll 8
          for (int h = 0; h < 64; ++h) s += hp[h] * w2[h * 64];
          (sl ? VCo : KCo)[(size_t)m * 64 + e] = s; } }
    __syncthreads();
}
struct BaseSample { const float* cache; const int* pt; int n0; __device__ __forceinline__ const float* operator()(int nl) const { const int n = n0 + nl; return cache + ((size_t)pt[n >> 1] * 128 + (n & 1) * 64) * 512; } };
struct BasePrompt { const float* kv; __device__ __forceinline__ const float* operator()(int nl) const { return kv + (size_t)nl * 64 * 512; } };

__device__ __forceinline__ void gating_chunk(Frame& F, int chunk, int half) {
    constexpr int VS = 132;
    const int w = F.wave, lane = F.lane, r32 = lane & 31, hi = lane >> 5, row0 = chunk * 128;
    LAS bf16* VNT = (LAS bf16*)F.lds;
    LAS float* stg = (LAS float*)(F.lds + 256 * VS * 2) + w * (32 * 33);
#pragma unroll 1
    for (int bt = 0; bt < 2; ++bt) {
        float x[8][8];
#pragma unroll
        for (int rr = 0; rr < 8; ++rr) { const float* vr = F.V + (size_t)(row0 + 16 * w + 8 * bt + rr) * 512;
#pragma unroll
            for (int j = 0; j < 8; ++j) x[rr][j] = vr[lane + 64 * j]; }
#pragma unroll
        for (int rr = 0; rr < 8; ++rr) { float sm = 0.f;
#pragma unroll
            for (int j = 0; j < 8; ++j) sm += x[rr][j];
            const float mean = wave_sum(sm) * (1.0f / 512.0f); float qq = 0.f;
#pragma unroll
            for (int j = 0; j < 8; ++j) { const float d = x[rr][j] - mean; qq += d * d; }
            const float rstd = 1.0f / sqrtf(wave_sum(qq) * (1.0f / 512.0f) + EPS); const int sidx = 16 * w + 8 * bt + rr;
#pragma unroll
            for (int j = 0; j < 4; ++j) { const int cl = lane + 64 * j, c = half * 256 + cl; const float xv = half ? x[rr][4 + j] : x[rr][j]; VNT[cl * VS + sidx] = f2bf((xv - mean) * rstd * F.lng[c] + F.lnb[c]); } }
    }
    __syncthreads();
    const int gl = w >> 2, db = w & 3, g = half * 2 + gl;
    f32x16 acc[4];
#pragma unroll
    for (int tb = 0; tb < 4; ++tb) acc[tb] = (f32x16){};
    const bf16* Wg = F.WSB + (size_t)g * 128 * 128 + (size_t)r32 * 128 + 8 * hi;
#pragma unroll
    for (int ks = 0; ks < 8; ++ks) {
        const LAS bf16* bp = VNT + (gl * 128 + 32 * db + r32) * VS + 16 * ks + 8 * hi;
        const v2u b0 = *(const LAS v2u*)bp, b1 = *(const LAS v2u*)(bp + 4); v4u bw; bw.x = b0.x; bw.y = b0.y; bw.z = b1.x; bw.w = b1.y; const bf16x8 bfr = __builtin_bit_cast(bf16x8, bw);
#pragma unroll
        for (int tb = 0; tb < 4; ++tb) if (ks <= 2 * tb + 1) acc[tb] = __builtin_amdgcn_mfma_f32_32x32x16_bf16(*(const bf16x8*)(Wg + (size_t)(32 * tb) * 128 + 16 * ks), bfr, acc[tb], 0, 0, 0);
    }
    const int c0 = g * 128 + 32 * db;
#pragma unroll
    for (int tb = 0; tb < 4; ++tb) {
#pragma unroll
        for (int r = 0; r < 16; ++r) { const int tl = crow(r, hi); stg[tl * 33 + r32] = acc[tb][r] + F.b_sp[g * 128 + 32 * tb + tl]; }
        LDS_WAIT();
#pragma unroll
        for (int it = 0; it < 2; ++it) { const int tl = (lane >> 2) + 16 * it, c8 = (lane & 3) * 8; const size_t o = (size_t)(row0 + 32 * tb + tl) * 512 + c0 + c8; float u[8], v[8]; ld8_act(F.U + o, u);
#pragma unroll
            for (int e = 0; e < 8; ++e) v[e] = u[e] * stg[tl * 33 + c8 + e];
            st8_act(F.YA + o, v); }
        LDS_WAIT();
    }
    __syncthreads();
}
__device__ __forceinline__ void gating_sample(Frame& F, int bs) {
    const int lane = F.lane; float vn[4][8];
#pragma unroll
    for (int t = 0; t < 4; ++t) { const int row = NP + bs * 4 + t; const float* vr = F.V + (size_t)row * 512; float s = 0.f;
#pragma unroll
        for (int j = 0; j < 8; ++j) { vn[t][j] = vr[lane + 64 * j]; s += vn[t][j]; }
        const float mean = wave_sum(s) * (1.0f / 512.0f); float q = 0.f;
#pragma unroll
        for (int j = 0; j < 8; ++j) { const float d = vn[t][j] - mean; q += d * d; }
        const float rstd = 1.0f / sqrtf(wave_sum(q) * (1.0f / 512.0f) + EPS);
#pragma unroll
        for (int j = 0; j < 8; ++j) { const int c = lane + 64 * j; vn[t][j] = (vn[t][j] - mean) * rstd * F.lng[c] + F.lnb[c]; F.out[O_VCH + (size_t)(bs * 4 + t) * 512 + c] = vn[t][j]; } }
#pragma unroll
    for (int t = 0; t < 4; ++t) { const int row = NP + bs * 4 + t;
#pragma unroll
        for (int j = 0; j < 8; ++j) { const int c = lane + 64 * j, g = j >> 1; float s = F.b_sp[g * 128 + t];
#pragma unroll
            for (int sp = 0; sp < 4; ++sp) if (sp <= t) s += F.w_sp[((size_t)g * 128 + t) * 128 + sp] * vn[sp][j];
            const size_t o = (size_t)row * 512 + c; st_act(F.YA + o, ld_act(F.U + o) * s); } }
}

__device__ __forceinline__ s16x4 vtr(const LAS bf16* p) { return __builtin_bit_cast(s16x4, __builtin_amdgcn_ds_read_tr16_b64_v4i16((LAS s16x4*)p)); }
constexpr int KTS = 72;
__device__ __forceinline__ void attn_tile(const LAS bf16* Kt, const LAS bf16* Vt, const bf16x8 (&qr)[4], unsigned valid0, unsigned valid1, float& m, float& l, f32x16 (&o)[2], LAS float* wsc, int lane) {
    const int r32 = lane & 31, hi = lane >> 5;
    f32x16 p0 = (f32x16){}, p1 = (f32x16){};
#pragma unroll
    for (int d0 = 0; d0 < 4; ++d0) {
        const bf16x8 k0 = *(const LAS bf16x8*)(Kt + r32 * KTS + 16 * d0 + 8 * hi), k1 = *(const LAS bf16x8*)(Kt + (32 + r32) * KTS + 16 * d0 + 8 * hi);
        p0 = __builtin_amdgcn_mfma_f32_32x32x16_bf16(k0, qr[d0], p0, 0, 0, 0); p1 = __builtin_amdgcn_mfma_f32_32x32x16_bf16(k1, qr[d0], p1, 0, 0, 0); }
    const bool full = (valid0 & valid1) == 0xffffu, none = (valid0 | valid1) == 0u;
    float mn, alpha, ls = 0.f;
    if (__all(full || none)) {
        float mt = fmaxf(fmaxf(p0[0], p0[1]), fmaxf(p1[0], p1[1]));
#pragma unroll
        for (int r = 2; r < 16; r += 2) mt = fmaxf(mt, fmaxf(fmaxf(p0[r], p0[r + 1]), fmaxf(p1[r], p1[r + 1])));
        mt = fmaxf(mt, __shfl_xor(mt, 32)); if (none) mt = NEGBIG;
        mn = fmaxf(m, mt); alpha = ex2(m - mn); m = mn;
        const float ms = none ? 1e30f : mn;
#pragma unroll
        for (int r = 0; r < 16; ++r) { p0[r] = ex2(p0[r] - ms); p1[r] = ex2(p1[r] - ms); ls += p0[r] + p1[r]; }
    } else {
        float mt = NEGBIG;
#pragma unroll
        for (int r = 0; r < 16; ++r) { if ((valid0 >> r) & 1u) mt = fmaxf(mt, p0[r]); if ((valid1 >> r) & 1u) mt = fmaxf(mt, p1[r]); }
        mt = fmaxf(mt, __shfl_xor(mt, 32));
        mn = fmaxf(m, mt); alpha = ex2(m - mn); m = mn;
#pragma unroll
        for (int r = 0; r < 16; ++r) { p0[r] = ((valid0 >> r) & 1u) ? ex2(p0[r] - mn) : 0.f; p1[r] = ((valid1 >> r) & 1u) ? ex2(p1[r] - mn) : 0.f; ls += p0[r] + p1[r]; }
    }
    ls += __shfl_xor(ls, 32); l = l * alpha + ls;
    if (!__all(alpha == 1.0f)) {
        if (hi == 0) wsc[96 + r32] = alpha;
        LDS_WAIT();
#pragma unroll
        for (int r = 0; r < 16; ++r) { const float a = wsc[96 + crow(r, hi)]; o[0][r] *= a; o[1][r] *= a; }
    }
    __builtin_amdgcn_sched_barrier(0);
    const int vrow = 4 * hi + ((lane & 15) >> 2), vcol = 16 * ((lane >> 4) & 1) + (lane & 3) * 4;
#pragma unroll
    for (int ph = 0; ph < 2; ++ph)
#pragma unroll
        for (int s = 0; s < 2; ++s) {
            const f32x16& pp = ph ? p1 : p0;
            const bf16x8 pa = pack8((f32x4){pp[8 * s], pp[8 * s + 1], pp[8 * s + 2], pp[8 * s + 3]}, (f32x4){pp[8 * s + 4], pp[8 * s + 5], pp[8 * s + 6], pp[8 * s + 7]});
#pragma unroll
            for (int db = 0; db < 2; ++db) {
                const LAS bf16* vp = Vt + (32 * ph + 16 * s + vrow) * KTS + 32 * db + vcol;
                const s16x4 lo = vtr(vp), hh = vtr(vp + 8 * KTS);
                const bf16x8 vb = (bf16x8){lo[0], lo[1], lo[2], lo[3], hh[0], hh[1], hh[2], hh[3]};
                o[db] = __builtin_amdgcn_mfma_f32_32x32x16_bf16(pa, vb, o[db], 0, 0, 0); }
        }
}
__device__ __forceinline__ void attn_prompt_unit(Frame& F, int b, int kvh, int j) {
    constexpr int OFF_KT = 0, OFF_VT = 18432, OFF_WSC = 36864, OFF_KCT = 40960, OFF_VCT = 45568, OFF_IMPS = 50176, OFF_MASK = OFF_IMPS + 64 * 33 * 4, OFF_MOR = OFF_MASK + 256, OFF_TL = OFF_MOR + 16, OFF_STASH = 59392;
    LAS bf16* KT = (LAS bf16*)(F.lds + OFF_KT); LAS bf16* VT = (LAS bf16*)(F.lds + OFF_VT); LAS bf16* KCT = (LAS bf16*)(F.lds + OFF_KCT); LAS bf16* VCT = (LAS bf16*)(F.lds + OFF_VCT);
    LAS float* IMPS = (LAS float*)(F.lds + OFF_IMPS); LAS unsigned* MASK = (LAS unsigned*)(F.lds + OFF_MASK); LAS unsigned* MOR = (LAS unsigned*)(F.lds + OFF_MOR); LAS int* TL = (LAS int*)(F.lds + OFF_TL);
    const int tid = F.tid, lane = F.lane, w = F.wave, r32 = lane & 31, hi = lane >> 5, g = w & 3, qs = w >> 2, h = kvh * 4 + g;
    LAS float* wsc = (LAS float*)(F.lds + OFF_WSC) + w * 128;
    LAS float* stash = (LAS float*)(F.lds + OFF_STASH) + w * 2048 + lane;
    const int row0 = b * TP + 64 * j, tq = 32 * qs + r32, t = 64 * j + tq, qrow = row0 + tq;
    bf16x8 qr[4];
#pragma unroll
    for (int d0 = 0; d0 < 4; ++d0) qr[d0] = *(const bf16x8*)(F.Q + (size_t)qrow * 512 + h * 64 + 16 * d0 + 8 * hi);
    { const int n = tid >> 4, d4 = (tid & 15) * 4; const size_t o = ((size_t)(b * 32 + n) * 2 + kvh) * 64 + d4; const f32x4 kc = *(const f32x4*)(F.KCP + o), vc = *(const f32x4*)(F.VCP + o);
      v2u a; a.x = pk2(kc[0], kc[1]); a.y = pk2(kc[2], kc[3]); *(LAS v2u*)(KCT + n * KTS + d4) = a; a.x = pk2(vc[0], vc[1]); a.y = pk2(vc[2], vc[3]); *(LAS v2u*)(VCT + n * KTS + d4) = a; }
    if (tid < 64) MASK[tid] = 0u;
    if (lane < 32) {
#pragma unroll
        for (int br = 0; br < 3; ++br) wsc[br * 32 + lane] = F.ZG[(size_t)(row0 + 32 * qs + lane) * 32 + br * 8 + h]; }
    __syncthreads();
    const int vrow = 4 * hi + ((lane & 15) >> 2), vcol = 16 * ((lane >> 4) & 1) + (lane & 3) * 4;
    {
        f32x16 pc = (f32x16){};
#pragma unroll
        for (int d0 = 0; d0 < 4; ++d0) pc = __builtin_amdgcn_mfma_f32_32x32x16_bf16(*(const LAS bf16x8*)(KCT + r32 * KTS + 16 * d0 + 8 * hi), qr[d0], pc, 0, 0, 0);
#if MK_DIAG_F32
        {
            const float* qf = F.QF + (size_t)qrow * 512 + h * 64;
#pragma unroll
            for (int r = 0; r < 16; ++r) { const float* kc = F.KCP + ((size_t)(b * 32 + crow(r, hi)) * 2 + kvh) * 64; float s = 0.f; for (int d = 0; d < 64; ++d) s += qf[d] * kc[d]; pc[r] = s; }
        }
#endif
        unsigned valid = 0u; float mt = NEGBIG;
#pragma unroll
        for (int r = 0; r < 16; ++r) { const int n = crow(r, hi); if ((n + 1) * 64 <= t + 1) { valid |= 1u << r; mt = fmaxf(mt, pc[r]); } }
        mt = fmaxf(mt, __shfl_xor(mt, 32)); float ls = 0.f;
#pragma unroll
        for (int r = 0; r < 16; ++r) { pc[r] = ((valid >> r) & 1u) ? ex2(pc[r] - mt) : 0.f; ls += pc[r]; }
        ls += __shfl_xor(ls, 32); const float inv = ls > 0.f ? 1.0f / ls : 0.f;
#pragma unroll
        for (int r = 0; r < 16; ++r) pc[r] *= inv;
        f32x16 oc[2]; oc[0] = (f32x16){}; oc[1] = (f32x16){};
#pragma unroll
        for (int s = 0; s < 2; ++s) {
            const bf16x8 pa = pack8((f32x4){pc[8 * s], pc[8 * s + 1], pc[8 * s + 2], pc[8 * s + 3]}, (f32x4){pc[8 * s + 4], pc[8 * s + 5], pc[8 * s + 6], pc[8 * s + 7]});
#pragma unroll
            for (int db = 0; db < 2; ++db) { const LAS bf16* vp = VCT + (16 * s + vrow) * KTS + 32 * db + vcol; const s16x4 lo = vtr(vp), hh = vtr(vp + 8 * KTS);
                oc[db] = __builtin_amdgcn_mfma_f32_32x32x16_bf16(pa, (bf16x8){lo[0], lo[1], lo[2], lo[3], hh[0], hh[1], hh[2], hh[3]}, oc[db], 0, 0, 0); } }
#pragma unroll
        for (int r = 0; r < 16; ++r) { const float gt = wsc[crow(r, hi)]; stash[r * 64] = oc[0][r] * gt; stash[(16 + r) * 64] = oc[1][r] * gt; }
        for (int gg = 0; gg < 4; ++gg) {
            if (g == gg) {
#pragma unroll
                for (int r = 0; r < 16; ++r) { LAS float* ip = IMPS + tq * 33 + crow(r, hi); *ip = (gg == 0 ? 0.f : *ip) + pc[r]; } }
            __syncthreads();
        }
    }
    for (int e = tid; e < 2048; e += NTHR) { const int q = e >> 5, n = e & 31; const float s = IMPS[q * 33 + n];
        IMPS[q * 33 + n] = (n == 0 || n == j || n == j - 1) ? 1e4f : (n > j ? -1.0f : s); }
    __syncthreads();
    { float an[4]; int rank[4];
#pragma unroll
      for (int c = 0; c < 4; ++c) { an[c] = IMPS[lane * 33 + 4 * w + c]; rank[c] = 0; }
#pragma unroll 8
      for (int mm = 0; mm < 32; ++mm) { const float am = IMPS[lane * 33 + mm];
#pragma unroll
          for (int c = 0; c < 4; ++c) rank[c] += (am > an[c] || (am == an[c] && mm < 4 * w + c)) ? 1 : 0; }
      unsigned bits = 0u;
#pragma unroll
      for (int c = 0; c < 4; ++c) if (rank[c] < 16) bits |= 1u << (4 * w + c);
      __hip_atomic_fetch_or(MASK + lane, bits, __ATOMIC_RELAXED, __HIP_MEMORY_SCOPE_WORKGROUP); }
    __syncthreads();
    if (w == 0) { unsigned v = MASK[lane];
#pragma unroll
        for (int o = 1; o < 64; o <<= 1) v |= (unsigned)__shfl_xor((int)v, o);
        if (lane == 0) { int n = 0; for (int jj = 0; jj <= j; ++jj) if ((v >> jj) & 1u) TL[1 + n++] = jj; const int nsel = n; const int jlo = j - 8 > 0 ? j - 8 : 0; for (int jj = j; jj >= jlo; --jj) TL[1 + n++] = 256 + jj; TL[0] = n | (nsel << 16); } }
    const unsigned mymask = MASK[tq];
    __syncthreads();
    const int ntile = TL[0] & 0xffff, nsel = TL[0] >> 16;
    const int ldkv = tid >> 3, ldch = (tid & 7) * 8;
    const size_t ldoff = (size_t)(b * TP + ldkv) * 256 + kvh * 64 + ldch;
    float m = NEGBIG, l = 0.f; f32x16 o[2]; o[0] = (f32x16){}; o[1] = (f32x16){};
    v4u kreg, vreg, kn;
    { const int e = TL[1]; const bf16* src = ((e >> 8) ? F.KVWB : F.KVSB) + ldoff + (size_t)(e & 255) * 64 * 256; kreg = *(const v4u*)src; vreg = *(const v4u*)(src + 128);
      const int e1 = TL[ntile > 1 ? 2 : 1]; const bf16* s1 = ((e1 >> 8) ? F.KVWB : F.KVSB) + ldoff + (size_t)(e1 & 255) * 64 * 256; kn = *(const v4u*)s1; }
    for (int k = 0; k < ntile; ++k) {
        const int e = TL[1 + k], jj = e & 255, buf = k & 1; const bool win = (e >> 8) != 0;
        *(LAS v4u*)(KT + buf * 4608 + ldkv * KTS + ldch) = kreg; *(LAS v4u*)(VT + buf * 4608 + ldkv * KTS + ldch) = vreg;
        kreg = kn;
        { const int k1 = k + 1 < ntile ? k + 1 : ntile - 1, k2 = k + 2 < ntile ? k + 2 : ntile - 1; const int e1 = TL[1 + k1], e2 = TL[1 + k2];
          vreg = *(const v4u*)(((e1 >> 8) ? F.KVWB : F.KVSB) + ldoff + (size_t)(e1 & 255) * 64 * 256 + 128); kn = *(const v4u*)(((e2 >> 8) ? F.KVWB : F.KVSB) + ldoff + (size_t)(e2 & 255) * 64 * 256); }
        if (k == nsel) {
            const float li = l > 0.f ? 1.0f / l : 0.f;
            if (hi == 0) wsc[96 + r32] = li * wsc[32 + r32];
            LDS_WAIT();
#pragma unroll
            for (int r = 0; r < 16; ++r) { const float fct = wsc[96 + crow(r, hi)]; stash[r * 64] += o[0][r] * fct; stash[(16 + r) * 64] += o[1][r] * fct; }
            m = NEGBIG; l = 0.f; o[0] = (f32x16){}; o[1] = (f32x16){};
        }
        __syncthreads();
        unsigned v0 = 0xffffu, v1 = 0xffffu;
        if (!win && !((mymask >> jj) & 1u)) { v0 = 0u; v1 = 0u; }
        else if (jj == j) { v0 = 0u; v1 = 0u;
#pragma unroll
            for (int r = 0; r < 16; ++r) { if (crow(r, hi) <= tq) v0 |= 1u << r; if (32 + crow(r, hi) <= tq) v1 |= 1u << r; } }
        else if (win && jj == j - 8) { v0 = 0u; v1 = 0u;
#pragma unroll
            for (int r = 0; r < 16; ++r) { if (crow(r, hi) > tq) v0 |= 1u << r; if (32 + crow(r, hi) > tq) v1 |= 1u << r; } }
        attn_tile(KT + buf * 4608, VT + buf * 4608, qr, v0, v1, m, l, o, wsc, lane);
    }
    {   const float li = l > 0.f ? 1.0f / l : 0.f;
        if (hi == 0) wsc[96 + r32] = li * wsc[64 + r32];
        LDS_WAIT();
#pragma unroll
        for (int db = 0; db < 2; ++db)
#pragma unroll
            for (int r = 0; r < 16; ++r) st_act(F.YB + (size_t)(row0 + 32 * qs + crow(r, hi)) * 512 + h * 64 + 32 * db + r32, stash[(16 * db + r) * 64] + o[db][r] * wsc[96 + crow(r, hi)]);
    }
    __syncthreads();
}

#if MK_DIAG_F32
__device__ __forceinline__ void gating_chunk_ref(Frame& F, int chunk) {
    const int row0 = chunk * 128; LAS float* stats = (LAS float*)F.lds; LAS float* VN = stats + 256;
    for (int rr = 0; rr < 16; ++rr) { const float* vr = F.V + (size_t)(row0 + 16 * F.wave + rr) * 512; float x[8], s = 0.f;
#pragma unroll
        for (int j = 0; j < 8; ++j) { x[j] = vr[F.lane + 64 * j]; s += x[j]; }
        const float mean = wave_sum(s) * (1.0f / 512.0f); float q = 0.f;
#pragma unroll
        for (int j = 0; j < 8; ++j) { const float d = x[j] - mean; q += d * d; }
        const float rstd = 1.0f / sqrtf(wave_sum(q) * (1.0f / 512.0f) + EPS);
        if (F.lane == 0) { stats[2 * (16 * F.wave + rr)] = mean; stats[2 * (16 * F.wave + rr) + 1] = rstd; } }
    for (int g = 0; g < 4; ++g) {
        __syncthreads();
        for (int e = F.tid; e < 128 * 128; e += NTHR) { const int s = e >> 7, d = e & 127, c = g * 128 + d; VN[e] = (F.V[(size_t)(row0 + s) * 512 + c] - stats[2 * s]) * stats[2 * s + 1] * F.lng[c] + F.lnb[c]; }
        __syncthreads();
        const int d = F.tid & 127;
        for (int t = F.tid >> 7; t < 128; t += 4) { float acc = F.b_sp[g * 128 + t]; const float* wr = F.w_sp + ((size_t)g * 128 + t) * 128;
            for (int s = 0; s <= t; ++s) acc += wr[s] * VN[s * 128 + d];
            const size_t o = (size_t)(row0 + t) * 512 + g * 128 + d; st_act(F.YA + o, ld_act(F.U + o) * acc); }
    }
    __syncthreads();
}
__device__ __forceinline__ void attn_prompt_ref(Frame& F, int b, int kvh, int t) {
    const int row = b * TP + t, cur = t >> 6, lane = F.lane; const float* kvp = F.out + O_KVP + (size_t)b * TP * 512;
    const bool av = lane < 32 && (lane + 1) * 64 <= t + 1;
    float imp = 0.f, pc0 = 0.f, pc1 = 0.f, pc2 = 0.f, pc3 = 0.f;
    for (int g = 0; g < 4; ++g) { const float q = F.QF[(size_t)row * 512 + (kvh * 4 + g) * 64 + lane]; float sc = NEGBIG;
        for (int n = 0; n < 32; ++n) { const float s = wave_sum(q * F.KCP[((size_t)(b * 32 + n) * 2 + kvh) * 64 + lane]); if (lane == n) sc = s; }
        const float m = wave_max(av ? sc : NEGBIG); const float p = av ? ex2(sc - m) : 0.f; const float l = wave_sum(p); const float pn = p / fmaxf(l, 1e-30f);
        imp += pn; if (g == 0) pc0 = pn; else if (g == 1) pc1 = pn; else if (g == 2) pc2 = pn; else pc3 = pn; }
    float a = (lane == 0 || lane == cur || lane == cur - 1) ? 1e4f : (lane > cur ? -1.0f : imp); if (lane >= 32) a = -2.0f;
    int rank = 0; for (int mm = 0; mm < 32; ++mm) { const float am = __shfl(a, mm); rank += (am > a || (am == a && mm < lane)) ? 1 : 0; }
    const unsigned mask = (unsigned)(__ballot(lane < 32 && rank < 16) & 0xffffffffull);
    for (int g = 0; g < 4; ++g) { const int h = kvh * 4 + g; const float q = F.QF[(size_t)row * 512 + h * 64 + lane];
        const float g0 = F.ZG[(size_t)row * 32 + h], g1 = F.ZG[(size_t)row * 32 + 8 + h], g2 = F.ZG[(size_t)row * 32 + 16 + h];
        const float pc = g == 0 ? pc0 : (g == 1 ? pc1 : (g == 2 ? pc2 : pc3)); float o = 0.f;
        for (int n = 0; n < 32; ++n) o += __shfl(pc, n) * g0 * F.VCP[((size_t)(b * 32 + n) * 2 + kvh) * 64 + lane];
        { float m = NEGBIG; for (int kp = 0; kp <= t; ++kp) { if (!((mask >> (kp >> 6)) & 1u)) continue; m = fmaxf(m, wave_sum(q * kvp[(size_t)kp * 512 + 256 + kvh * 64 + lane])); }
          float l = 0.f, os = 0.f;
          for (int kp = 0; kp <= t; ++kp) { if (!((mask >> (kp >> 6)) & 1u)) continue; const float* kk = kvp + (size_t)kp * 512 + 256 + kvh * 64; const float pp = ex2(wave_sum(q * kk[lane]) - m); l += pp; os += pp * kk[128 + lane]; }
          o += os * (g1 / fmaxf(l, 1e-30f)); }
        { const int k0 = t - 511 > 0 ? t - 511 : 0; float m = NEGBIG; for (int kp = k0; kp <= t; ++kp) m = fmaxf(m, wave_sum(q * F.KVWF[(size_t)(b * TP + kp) * 256 + kvh * 64 + lane]));
          float l = 0.f, os = 0.f;
          for (int kp = k0; kp <= t; ++kp) { const float* kk = F.KVWF + (size_t)(b * TP + kp) * 256 + kvh * 64; const float pp = ex2(wave_sum(q * kk[lane]) - m); l += pp; os += pp * kk[128 + lane]; }
          o += os * (g2 / fmaxf(l, 1e-30f)); }
        st_act(F.YB + (size_t)row * 512 + h * 64 + lane, o);
    }
}
#endif
constexpr int SCS = 1088;
struct KeysCmp { const float* kc; const float* vc; __device__ __forceinline__ void operator()(int k, const float*& K, const float*& V) const { K = kc + (size_t)k * 128; V = vc + (size_t)k * 128; } };
struct KeysSel { const float* cache; const LAS int* listr; const float* newk; int kvh; __device__ __forceinline__ void operator()(int k, const float*& K, const float*& V) const {
    if (k < 960) { const size_t r = (size_t)listr[k >> 6] + (k & 63); K = cache + (r * 4 + 2) * 128 + kvh * 64; V = K + 128; } else { K = newk + (size_t)(k - 960) * 512; V = K + 128; } } };
struct KeysWin { const float* prev; const float* neww; int nprev, t; __device__ __forceinline__ void operator()(int k, const float*& K, const float*& V) const {
    if (k < nprev) { K = prev + (size_t)(t + 1 + k) * 256; V = K + 128; } else { K = neww + (size_t)(k - nprev) * 256; V = K + 128; } } };
template <bool WANT_IMP, class KeyFn> __device__ __forceinline__ float small_attn(Frame& F, const float (&q)[4][4], int nkeys, const KeyFn& keyfn) {
    LAS float* SC = (LAS float*)F.lds; LAS float* IMP = SC + 4 * SCS; LAS float* ML = IMP + 272; LAS float* PM = ML + 16; LAS float* PO = PM + 256;
    const int lane = F.lane, w = F.wave, kl = lane >> 4, dl = lane & 15;
    float m[4], l[4], o[4][4];
#pragma unroll
    for (int g = 0; g < 4; ++g) { m[g] = NEGBIG; l[g] = 0.f;
#pragma unroll
        for (int e = 0; e < 4; ++e) o[g][e] = 0.f; }
    for (int kb = 0; kb < nkeys; kb += 128) {
        f32x4 kv[4], vv[4]; bool ok[4];
#pragma unroll
        for (int u = 0; u < 4; ++u) { const int k = kb + 32 * u + w * 4 + kl; ok[u] = k < nkeys; kv[u] = (f32x4){0.f, 0.f, 0.f, 0.f}; vv[u] = kv[u];
            if (ok[u]) { const float *K, *V; keyfn(k, K, V); kv[u] = *(const f32x4*)(K + 4 * dl); vv[u] = *(const f32x4*)(V + 4 * dl); } }
#pragma unroll
        for (int u = 0; u < 4; ++u) { const int k = kb + 32 * u + w * 4 + kl;
#pragma unroll
            for (int g = 0; g < 4; ++g) { float s = (q[g][0] * kv[u][0] + q[g][1] * kv[u][1]) + (q[g][2] * kv[u][2] + q[g][3] * kv[u][3]);
                s += __shfl_xor(s, 1); s += __shfl_xor(s, 2); s += __shfl_xor(s, 4); s += __shfl_xor(s, 8);
                if (ok[u]) { if (WANT_IMP && dl == 0) SC[g * SCS + k] = s;
                    const float mn = fmaxf(m[g], s), sc = ex2(m[g] - mn), pp = ex2(s - mn); m[g] = mn; l[g] = l[g] * sc + pp;
#pragma unroll
                    for (int e = 0; e < 4; ++e) o[g][e] = o[g][e] * sc + pp * vv[u][e]; } } }
    }
    { const int grp = w * 4 + kl;
#pragma unroll
      for (int g = 0; g < 4; ++g) { if (dl == 0) { PM[(grp * 4 + g) * 2] = m[g]; PM[(grp * 4 + g) * 2 + 1] = l[g]; } *(LAS f32x4*)(PO + (grp * 4 + g) * 64 + 4 * dl) = (f32x4){o[g][0], o[g][1], o[g][2], o[g][3]}; } }
    __syncthreads();
    float res = 0.f;
    if (F.tid < 256) { const int g = F.tid >> 6, d = F.tid & 63; float M = NEGBIG;
        for (int grp = 0; grp < 32; ++grp) M = fmaxf(M, PM[(grp * 4 + g) * 2]);
        float L = 0.f;
        for (int grp = 0; grp < 32; ++grp) { const float f = ex2(PM[(grp * 4 + g) * 2] - M); L += PM[(grp * 4 + g) * 2 + 1] * f; res += PO[(grp * 4 + g) * 64 + d] * f; }
        const float inv = 1.0f / L; res *= inv; if (d == 0) { ML[g] = M; ML[4 + g] = inv; } }
    __syncthreads();
    if (WANT_IMP) { for (int k = F.tid; k < nkeys; k += NTHR) IMP[k] = (ex2(SC[k] - ML[0]) * ML[4] + ex2(SC[SCS + k] - ML[1]) * ML[5]) + (ex2(SC[2 * SCS + k] - ML[2]) * ML[6] + ex2(SC[3 * SCS + k] - ML[3]) * ML[7]);
        __syncthreads(); }
    return res;
}
__device__ __forceinline__ void attn_sample_unit(Frame& F, int bs, int t, int kvh) {
    LAS float* SC = (LAS float*)F.lds; LAS float* IMP = SC + 4 * SCS; LAS unsigned* FLG = (LAS unsigned*)(IMP + 272 + 16 + 256 + 32 * 4 * 64); LAS int* LISTR = (LAS int*)(FLG + 256);
    const int tid = F.tid, lane = F.lane, dl = lane & 15, row = NP + bs * 4 + t;
    float q[4][4];
#pragma unroll
    for (int g = 0; g < 4; ++g)
#pragma unroll
        for (int e = 0; e < 4; ++e) q[g][e] = F.QS[(size_t)(row - NP) * 512 + (kvh * 4 + g) * 64 + 4 * dl + e];
    const int hme = kvh * 4 + (tid >> 6);
    float gate[3];
#pragma unroll
    for (int br = 0; br < 3; ++br) gate[br] = tid < 256 ? F.ZG[(size_t)row * 32 + br * 8 + hme] : 0.f;
    const KeysCmp kc{F.KCS + ((size_t)bs * 256 * 2 + kvh) * 64, F.VCS + ((size_t)bs * 256 * 2 + kvh) * 64};
    float acc = gate[0] * small_attn<true>(F, q, 256, kc);
    if (tid >= 1 && tid <= 254) { const float a = IMP[tid]; int rank = 0; for (int mm = 1; mm <= 254; ++mm) { const float am = IMP[mm]; rank += (am > a || (am == a && mm < tid)) ? 1 : 0; } FLG[tid] = rank < 13 ? 1u : 0u; }
    if (tid == 0 || tid == 255) FLG[tid] = 0u;
    __syncthreads();
    if (tid < 256) { const int n = tid; const int ridx = F.ptab[bs * 128 + (n >> 1)] * 128 + (n & 1) * 64;
        if (n == 0) LISTR[0] = ridx; else if (n == 255) LISTR[14] = ridx; else if (FLG[n]) { int pos = 0; for (int mm = 1; mm < n; ++mm) pos += (int)FLG[mm]; LISTR[1 + pos] = ridx; } }
    __syncthreads();
    const KeysSel ksel{F.cache, LISTR, F.out + O_KVS + (size_t)(bs * 4) * 512 + 2 * 128 + kvh * 64, kvh};
    acc += gate[1] * small_attn<false>(F, q, 960 + t + 1, ksel);
    const KeysWin kwin{F.st_win + (size_t)bs * 512 * 256 + kvh * 64, F.out + O_WINS + ((size_t)bs * 512 + 508) * 256 + kvh * 64, 511 - t, t};
    acc += gate[2] * small_attn<false>(F, q, 512, kwin);
    if (tid < 256) st_act(F.YB + (size_t)row * 512 + hme * 64 + (tid & 63), acc);
    __syncthreads();
}

__global__ void __launch_bounds__(NTHR, 2) mk_fwd(Args args) {
    extern __shared__ __attribute__((aligned(16))) unsigned char lds_raw[];
    Frame F;
    F.lds = (LAS unsigned char*)lds_raw; F.tid = threadIdx.x; F.lane = F.tid & 63; F.wave = __builtin_amdgcn_readfirstlane(F.tid >> 6); F.G = gridDim.x; F.bid = blockIdx.x;
    F.x_p = (const float*)args.in[0]; F.x_s = (const float*)args.in[1]; F.cache = (const float*)args.in[2]; F.st_win = (const float*)args.in[3]; F.st_conv = (const float*)args.in[4]; F.ptab = (const int*)args.in[5];
    F.c_p = (const float*)args.in[6]; F.c_s = (const float*)args.in[7]; F.w_ada = (const float*)args.in[8]; F.b_ada = (const float*)args.in[9]; F.g1 = (const float*)args.in[10]; F.w_in = (const float*)args.in[11];
    F.lng = (const float*)args.in[12]; F.lnb = (const float*)args.in[13]; F.w_sp = (const float*)args.in[14]; F.b_sp = (const float*)args.in[15]; F.pe = (const float*)args.in[16]; F.cw1 = (const float*)args.in[17];
    F.cb1 = (const float*)args.in[18]; F.cw2 = (const float*)args.in[19]; F.cb2 = (const float*)args.in[20]; F.w_a = (const float*)args.in[21]; F.w_b = (const float*)args.in[22]; F.w_out = (const float*)args.in[23];
    F.g2 = (const float*)args.in[24]; F.w_up = (const float*)args.in[25]; F.w_conv = (const float*)args.in[26]; F.b_conv = (const float*)args.in[27]; F.w_dn = (const float*)args.in[28]; F.g_fin = (const float*)args.in[29];
    F.out = args.out; unsigned char* ws = args.ws; F.ws = ws;
    F.PRE = (float*)(ws + WS_PRE); F.UPS = (float*)(ws + WS_UPS); F.TAIL = (float*)(ws + WS_TAIL); F.HEAD = (float*)(ws + WS_HEAD); F.MOD = (float*)(ws + WS_MOD); F.B1P = (float*)(ws + WS_B1P); F.KCP = (float*)(ws + WS_KCP); F.VCP = (float*)(ws + WS_VCP); F.KCS = (float*)(ws + WS_KCS); F.VCS = (float*)(ws + WS_VCS);
    F.V = (float*)(ws + WS_V); F.ZG = (float*)(ws + WS_ZG); F.MIXF = (float*)(ws + WS_MIXF); F.X1 = (float*)(ws + WS_X1); F.X2 = (float*)(ws + WS_X2);
    F.WSB = (bf16*)(ws + WS_WSB); F.KVWF = (float*)(ws + WS_KVWF); F.QF = (float*)(ws + WS_QF); F.QS = (float*)(ws + WS_QS); F.W1L = (bf16*)(ws + WS_W1L); F.W1F = (bf16*)(ws + WS_W1F); F.WIN = (bf16*)(ws + WS_WIN); F.WA = (bf16*)(ws + WS_WA); F.WB = (bf16*)(ws + WS_WB); F.WOUT = (bf16*)(ws + WS_WOUT); F.WUP = (bf16*)(ws + WS_WUP); F.WDN = (bf16*)(ws + WS_WDN);
    F.Q = (bf16*)(ws + WS_Q); F.KVSB = (bf16*)(ws + WS_KVSB); F.KVWB = (bf16*)(ws + WS_KVWB);
    F.HN = (act_t*)(ws + WS_HN); F.U = (act_t*)(ws + WS_U); F.GAB = (act_t*)(ws + WS_GAB); F.YA = (act_t*)(ws + WS_YA); F.YB = (act_t*)(ws + WS_YB); F.MIX = (act_t*)(ws + WS_MIX); F.H2 = (act_t*)(ws + WS_H2);
    F.UP = (act_t*)(ws + WS_UP); F.ACT = (act_t*)(ws + WS_ACT);
    for (int u = F.tid; u < (LDS_BYTES - RING_BYTES) / 4; u += NTHR) ((LAS unsigned*)(F.lds + RING_BYTES))[u] = 0u;
    __syncthreads();
    unsigned* ctl = (unsigned*)(ws + WS_CTL);
    XcdBarrier bar; bar.bar = ctl + CW_BAR; bar.x = 0; bar.st = nullptr;
#if MK_N_LAUNCHES == 1
    bar = xcd_barrier_post(ctl + CW_BAR, (volatile LAS unsigned*)(F.lds + MISC_OFF) + 8);
#define GRID_BAR() xcd_barrier(bar)
#else
#define GRID_BAR() do {} while (0)
#endif
    const int lo = args.ph_lo, hi = args.ph_hi;
#ifndef MK_PH_MASK
#define MK_PH_MASK 0xffff
#endif
#define IN(k) (((MK_PH_MASK >> (k)) & 1) && lo <= (k) && (k) < hi)
#define SEAM(k) do { if (IN(k) && IN((k) + 1)) GRID_BAR(); } while (0)
#ifndef MK_REP_MASK
#define MK_REP_MASK 0
#endif
    const int gw = F.bid * NWV + F.wave, NGW = F.G * NWV;

    if (IN(0)) { p0_prologue(F); } SEAM(0);

    if (IN(1)) {
        for (int row = gw; row < NR; row += 4 * NGW) {
            const float* xr[4]; const float* sh[4]; const float* sc[4]; act_t* orow[4];
#pragma unroll
            for (int k = 0; k < 4; ++k) { const int r = row + k * NGW < NR ? row + k * NGW : row; const float* mod = F.MOD + (size_t)seq_of(r) * MODC; xr[k] = xrow_of(F, r); sh[k] = mod; sc[k] = mod + 1024; orow[k] = F.HN + (size_t)r * DM; }
            rms_rows<true, 4>(xr, F.g1, sh, sc, orow, F.lane); }
        for (size_t i = (size_t)F.bid * NTHR + F.tid; i < (size_t)NSB * 508 * 64; i += (size_t)F.G * NTHR) { const size_t bs = i / (508 * 64), r = i % (508 * 64);
            *(f32x4*)(F.out + O_WINS + bs * 512 * 256 + r * 4) = *(const f32x4*)(F.st_win + bs * 512 * 256 + 4 * 256 + r * 4); }
    }

    if (IN(2)) {
        for (int u = F.bid; u < NSB * 8; u += F.G) { const int bs = u >> 3, g8 = u & 7; const BaseSample bf{F.cache, F.ptab + bs * 128, 32 * g8};
            compress_unit<2, 64, false>(F, bf, 0, F.KCS + ((size_t)bs * 256 + 32 * g8) * 128, F.VCS + ((size_t)bs * 256 + 32 * g8) * 128, nullptr, 0, nullptr); }
    } SEAM(2);

    if (IN(3)) { const EpiIn E{F.ws, F.out}; run_gemm<true>(F, F.HN, F.w_in, 4376, MapIn(), F.WIN, INP, DM, 4376, E); } SEAM(3);

    if (IN(4)) {
#if MK_DIAG_F32 && MK_REF_GATING
        for (int c = F.bid; c < NP / 128; c += F.G) gating_chunk_ref(F, c);
#else
        for (int c = F.bid; c < NP / 64; c += F.G) gating_chunk(F, c >> 1, c & 1);
#endif
        for (int u = F.G - 1 - F.bid; u < NPB * 2 * 4; u += F.G) { const int grp = u >> 2, kq = u & 3; const BasePrompt bf{F.out + O_KVP + ((size_t)(grp >> 1) * TP + (grp & 1) * 1024) * 512};
            compress_unit<1, 16, true>(F, bf, 16 * kq, F.KCP + (size_t)grp * 16 * 128, F.VCP + (size_t)grp * 16 * 128, F.PRE + (size_t)grp * 4 * 4096, kq, ctl + CW_CMP + 64 * grp); }
        { const int sb = ((F.G - 65 - F.bid) % F.G + F.G) % F.G; for (int s = sb * NWV + F.wave; s < NSB; s += NGW) gating_sample(F, s); }
    } SEAM(4);

    if (IN(5)) {
        for (int u = F.bid; u < NSB * TS * 2; u += F.G) attn_sample_unit(F, u >> 3, (u >> 1) & 3, u & 1);
#if MK_DIAG_F32 && MK_REF_ATTN
        for (int i = gw; i < NP * 2; i += NGW) attn_prompt_ref(F, i >> 12, (i >> 11) & 1, i & 2047);
#else
        for (int p = F.bid; p < 256; p += F.G) { const int b = p >> 5, kvh = (p >> 4) & 1, jl = p & 15;
#pragma unroll 1
            for (int i = 0; i < 2; ++i) attn_prompt_unit(F, b, kvh, i ? jl : 31 - jl); }
#endif
    } SEAM(5);

    if (IN(6)) {
        { const EpiBrA E{F.MIXF, F.GAB}; run_gemm<false>(F, F.YA, F.w_a, DM, MapId(), F.WA, DM, AW, DM, E); }
        { const EpiBrB E{F.MIXF, F.GAB, F.MIX}; run_gemm<false>(F, F.YB, F.w_b, DM, MapId(), F.WB, DM, AW, DM, E); }
    } SEAM(6);

    if (IN(7)) { const EpiRes E{F.x_p, F.x_s, F.MOD, 2048, F.X1}; run_gemm<false>(F, F.MIX, F.w_out, DM, MapId(), F.WOUT, DM, DM, DM, E); } SEAM(7);

    if (IN(8)) { for (int row = gw; row < NR; row += 4 * NGW) {
            const float* xr[4]; const float* sh[4]; const float* sc[4]; act_t* orow[4];
#pragma unroll
            for (int k = 0; k < 4; ++k) { const int r = row + k * NGW < NR ? row + k * NGW : row; const float* mod = F.MOD + (size_t)seq_of(r) * MODC; xr[k] = F.X1 + (size_t)r * DM; sh[k] = mod + 3072; sc[k] = mod + 4096; orow[k] = F.H2 + (size_t)r * DM; }
            rms_rows<true, 4>(xr, F.g2, sh, sc, orow, F.lane); } } SEAM(8);

#if MK_DIAG_F32
    if (IN(9)) { const EpiUp E{F.UP, F.out}; run_gemm<true>(F, F.H2, F.w_up, UPC, MapId(), F.WUP, UPC, DM, UPC, E); } SEAM(9);
#else
    if (IN(9)) { const EpiUpConv E{F.ws, F.out, F.w_conv, F.b_conv, (LAS float*)(F.lds + RING_BYTES + 1024)};
        pg8::Gemm g{F.H2, F.WUP, NRP, UPC, DM}; pg8::StaticOrder S; S.init(NRP, UPC, F.G, F.bid); pg8::gemm_phase<EpiUpConv, pg8::StaticOrder, true, true>(F.lds, g, S, E); } SEAM(9);
#endif

#if !MK_DIAG_F32
    if (IN(10)) {
        for (int i = F.bid * NTHR + F.tid; i < 56 * 2 * (DFF / 8); i += F.G * NTHR) {
            const int j0 = (i % (DFF / 8)) * 8, rt = i / (DFF / 8), t = rt & 1, k7 = rt >> 1, pm = (k7 / 7) * 8 + 1 + (k7 % 7); const int na = 256 * (j0 >> 7) + (j0 & 127);
            const float* h0 = F.HEAD + ((size_t)pm * 2) * UPC; const float* tl = F.TAIL + ((size_t)(pm - 1) * 2) * UPC;
            const float* r2p = t ? h0 + UPC : h0; const float* r1p = t ? h0 : tl + UPC; const float* r0p = t ? tl + UPC : tl; float o[8], ca[8], cg[8];
#pragma unroll
            for (int hf = 0; hf < 2; ++hf) { const int nn = na + hf * 128, j = j0 + hf * DFF; float w0[8], w1[8], w2[8], u0[8], u1[8], u2[8]; float* cc = hf ? cg : ca;
                ld8_f32(F.w_conv + j, w0); ld8_f32(F.w_conv + UPC + j, w1); ld8_f32(F.w_conv + 2 * UPC + j, w2); ld8_f32(F.b_conv + j, cc); ld8_f32(r0p + nn, u0); ld8_f32(r1p + nn, u1); ld8_f32(r2p + nn, u2);
#pragma unroll
                for (int e = 0; e < 8; ++e) cc[e] += w0[e] * u0[e] + w1[e] * u1[e] + w2[e] * u2[e]; }
#pragma unroll
            for (int e = 0; e < 8; ++e) o[e] = gelu_t(ca[e]) * cg[e];
            st8_act(F.ACT + (size_t)(pm * 256 + t) * DFF + j0, o); }
        for (int i = F.bid * NTHR + F.tid; i < NS * (DFF / 8); i += F.G * NTHR) {
            const int rs = i / (DFF / 8), j0 = (i % (DFF / 8)) * 8, t = rs & 3, na = 256 * (j0 >> 7) + (j0 & 127); const float* pv = F.st_conv + (size_t)(rs >> 2) * 2 * UPC; float o[8], ca[8], cg[8];
#pragma unroll
            for (int hf = 0; hf < 2; ++hf) { const int nn = na + hf * 128, j = j0 + hf * DFF; float w0[8], w1[8], w2[8], u0[8], u1[8], u2[8]; float* cc = hf ? cg : ca;
                ld8_f32(F.w_conv + j, w0); ld8_f32(F.w_conv + UPC + j, w1); ld8_f32(F.w_conv + 2 * UPC + j, w2); ld8_f32(F.b_conv + j, cc); ld8_f32(F.UPS + (size_t)rs * UPC + nn, u2);
                if (t >= 1) ld8_f32(F.UPS + (size_t)(rs - 1) * UPC + nn, u1); else ld8_f32(pv + UPC + j, u1);
                if (t >= 2) ld8_f32(F.UPS + (size_t)(rs - 2) * UPC + nn, u0); else ld8_f32(pv + (size_t)t * UPC + j, u0);
                if (t >= 2) st8_f32(F.out + O_CONVS + ((size_t)(rs >> 2) * 2 + (t - 2)) * UPC + j, u2);
#pragma unroll
                for (int e = 0; e < 8; ++e) cc[e] += w0[e] * u0[e] + w1[e] * u1[e] + w2[e] * u2[e]; }
#pragma unroll
            for (int e = 0; e < 8; ++e) o[e] = gelu_t(ca[e]) * cg[e];
            st8_act(F.ACT + (size_t)(NP + rs) * DFF + j0, o); }
    } SEAM(10);
#else
    if (IN(10)) {
        for (int it = F.bid * NTHR + F.tid; it < (NP / 64) * (DFF / 8); it += F.G * NTHR) {
            const int rc = it / (DFF / 8), j0 = (it % (DFF / 8)) * 8, row0 = rc * 64;
            float w0a[8], w1a[8], w2a[8], ba[8], w0g[8], w1g[8], w2g[8], bg[8], pa1[8], pa0[8], pg1[8], pg0[8];
            ld8_f32(F.w_conv + j0, w0a); ld8_f32(F.w_conv + UPC + j0, w1a); ld8_f32(F.w_conv + 2 * UPC + j0, w2a); ld8_f32(F.b_conv + j0, ba);
            ld8_f32(F.w_conv + DFF + j0, w0g); ld8_f32(F.w_conv + UPC + DFF + j0, w1g); ld8_f32(F.w_conv + 2 * UPC + DFF + j0, w2g); ld8_f32(F.b_conv + DFF + j0, bg);
            if ((row0 & (TP - 1)) == 0) {
#pragma unroll
                for (int e = 0; e < 8; ++e) { pa1[e] = 0.f; pa0[e] = 0.f; pg1[e] = 0.f; pg0[e] = 0.f; } }
            else { ld8_act(F.UP + (size_t)(row0 - 1) * UPC + j0, pa1); ld8_act(F.UP + (size_t)(row0 - 2) * UPC + j0, pa0); ld8_act(F.UP + (size_t)(row0 - 1) * UPC + DFF + j0, pg1); ld8_act(F.UP + (size_t)(row0 - 2) * UPC + DFF + j0, pg0); }
#pragma unroll 4
            for (int r = 0; r < 64; ++r) { const size_t ro = (size_t)(row0 + r) * UPC + j0; float ua[8], ug[8], o[8]; ld8_act(F.UP + ro, ua); ld8_act(F.UP + ro + DFF, ug);
#pragma unroll
                for (int e = 0; e < 8; ++e) { const float ca = ba[e] + w0a[e] * pa0[e] + w1a[e] * pa1[e] + w2a[e] * ua[e], cg = bg[e] + w0g[e] * pg0[e] + w1g[e] * pg1[e] + w2g[e] * ug[e];
                    o[e] = gelu_t(ca) * cg; pa0[e] = pa1[e]; pa1[e] = ua[e]; pg0[e] = pg1[e]; pg1[e] = ug[e]; }
                st8_act(F.ACT + (size_t)(row0 + r) * DFF + j0, o); }
        }
        for (int i = F.bid * NTHR + F.tid; i < NS * (DFF / 8); i += F.G * NTHR) {
            const int row = NP + i / (DFF / 8), j0 = (i % (DFF / 8)) * 8; float ca[8], cg[8], w0[8], w1[8], w2[8], u0[8], u1[8], u2[8];
            const int t = (row - NP) & 3; const float* pv = F.st_conv + (size_t)((row - NP) >> 2) * 2 * UPC;
#pragma unroll
            for (int hf = 0; hf < 2; ++hf) { const int j = j0 + hf * DFF; float* cc = hf ? cg : ca;
                ld8_f32(F.w_conv + j, w0); ld8_f32(F.w_conv + UPC + j, w1); ld8_f32(F.w_conv + 2 * UPC + j, w2); ld8_f32(F.b_conv + j, cc);
                ld8_act(F.UP + (size_t)row * UPC + j, u2);
                if (t >= 1) ld8_act(F.UP + (size_t)(row - 1) * UPC + j, u1); else ld8_f32(pv + UPC + j, u1);
                if (t >= 2) ld8_act(F.UP + (size_t)(row - 2) * UPC + j, u0); else ld8_f32(pv + (size_t)t * UPC + j, u0);
#pragma unroll
                for (int e = 0; e < 8; ++e) cc[e] += w0[e] * u0[e] + w1[e] * u1[e] + w2[e] * u2[e]; }
#pragma unroll
            for (int e = 0; e < 8; ++e) ca[e] = gelu_t(ca[e]) * cg[e];
            st8_act(F.ACT + (size_t)row * DFF + j0, ca); }
    } SEAM(10);
#endif

    if (IN(11)) { const EpiRes E{F.X1, F.X1 + (size_t)NP * DM, F.MOD, 5120, F.X2}; run_gemm<false>(F, F.ACT, F.w_dn, DM, MapId(), F.WDN, DM, DFF, DM, E); } SEAM(11);

    if (IN(12)) { for (int row = gw; row < NR; row += 4 * NGW) {
            const float* xr[4]; const float* sh[4]; const float* sc[4]; float* orow[4];
#pragma unroll
            for (int k = 0; k < 4; ++k) { const int r = row + k * NGW < NR ? row + k * NGW : row; xr[k] = F.X2 + (size_t)r * DM; sh[k] = nullptr; sc[k] = nullptr; orow[k] = r < NP ? F.out + O_YP + (size_t)r * DM : F.out + O_YS + (size_t)(r - NP) * DM; }
            rms_rows<false, 4>(xr, F.g_fin, sh, sc, orow, F.lane); } }
#undef IN
#undef SEAM
}

constexpr int NPHASES = 13;
extern "C" void kernel_launch(void* const* d_in, const int* in_sizes, int n_in, void* d_out, int out_size, void* d_ws, size_t ws_size, hipStream_t stream) {
    static int grid = 0;
    if (grid == 0) {
        if (n_in != 30 || out_size != (int)O_END || ws_size < WS_END) { fprintf(stderr, "kernel_launch: unexpected problem shape (n_in %d, out %d, ws %zu < %zu)\n", n_in, out_size, ws_size, (size_t)WS_END); grid = -1; return; }
        int dev = 0, cus = 0;
        if (hipGetDevice(&dev) != hipSuccess || hipDeviceGetAttribute(&cus, hipDeviceAttributeMultiprocessorCount, dev) != hipSuccess) { grid = -1; return; }
        if (hipFuncSetAttribute((const void*)mk_fwd, hipFuncAttributeMaxDynamicSharedMemorySize, LDS_BYTES) != hipSuccess) { fprintf(stderr, "kernel_launch: hipFuncSetAttribute failed\n"); grid = -1; return; }
        int per_cu = 0;
        if (hipOccupancyMaxActiveBlocksPerMultiprocessor(&per_cu, (const void*)mk_fwd, NTHR, LDS_BYTES) != hipSuccess || per_cu < 1) { fprintf(stderr, "kernel_launch: occupancy query says %d blocks per CU\n", per_cu); }
        (void)hipGetLastError();
        grid = cus;
    }
    if (grid < 0) return;
    (void)hipMemsetAsync((char*)d_ws + WS_CTL, 0, CTL_ZERO_BYTES, stream);
    Args a{};
    for (int i = 0; i < 30; ++i) a.in[i] = d_in[i];
    a.out = (float*)d_out; a.ws = (unsigned char*)d_ws; a.li = 0; a.pad = 0;
#if MK_N_LAUNCHES == 1
    a.ph_lo = 0; a.ph_hi = NPHASES;
    hipLaunchKernelGGL(mk_fwd, dim3(grid), dim3(NTHR), LDS_BYTES, stream, a);
#else
    for (int p = 0; p < NPHASES; ++p) { a.ph_lo = p; a.ph_hi = p + 1; const int nrep = ((MK_REP_MASK >> p) & 1) ? 3 : 1;
        for (int r = 0; r < nrep; ++r) hipLaunchKernelGGL(mk_fwd, dim3(grid), dim3(NTHR), LDS_BYTES, stream, a); }
#endif
}
```

```cpp
#include <hip/hip_runtime.h>
#include <hip/hip_bf16.h>
#include <cstdio>
#include <cstdint>
#ifndef MK_DIAG_F32
#define MK_DIAG_F32 0
#endif
#ifndef MK_N_LAUNCHES
#define MK_N_LAUNCHES 1
#endif
#ifndef MK_REF_ATTN
#define MK_REF_ATTN 0
#endif
#ifndef MK_REF_GATING
#define MK_REF_GATING 0
#endif
namespace pg8 {
#define PG8_LAS __attribute__((address_space(3)))
typedef unsigned short bf16_t;
typedef short bf16x8 __attribute__((ext_vector_type(8)));
typedef float f32x4 __attribute__((ext_vector_type(4)));
typedef unsigned u32x4 __attribute__((ext_vector_type(4)));
constexpr int BM = 256, BK = 64, HALF = 128, HTB = HALF * BK * 2  , STAGE_BYTES = 8 * HTB, NXCD = 8, WGM = 8;

__host__ __device__ __forceinline__ int lds_byte(int r, int c) { const int st = (r >> 4) * 2 + (c >> 5), rr = r & 15, cc = c & 31, ob = rr * 64 + cc * 2; return st * 1024 + (ob ^ (((ob >> 9) & 1) << 5)); }
__host__ __device__ __forceinline__ void stage_rc(int b, int& R, int& C) { const int st = b / 1024, sb = b % 1024, swz = sb ^ (((sb >> 9) & 1) << 5); R = (st >> 1) * 16 + swz / 64; C = (st & 1) * 32 + (swz % 64) / 2; }
__host__ __device__ __forceinline__ int perm32(int rho) { const int n = rho >> 4, i = rho & 15; return 8 * (i >> 2) + 4 * n + (i & 3); }

struct Unit { int pm, pn; };
struct Gemm { const bf16_t* A; const bf16_t* Bt; int M, N, K; };

struct StaticOrder {
    int nM, nN, nwg, G, c;
    __host__ __device__ void init(int M, int N, int G_, int c_) { nM = M / BM; nN = N / BM; nwg = nM * nN; G = G_; c = c_; }
    __host__ __device__ bool next(int i, Unit& u) const {
        const long L = (long)i * G + c; if (L >= nwg) return false;
        int wgid = (int)L; { const int q = nwg / NXCD, r = nwg % NXCD, xcd = wgid % NXCD, off = wgid / NXCD; wgid = (xcd < r ? xcd * (q + 1) : r * (q + 1) + (xcd - r) * q) + off; }
        const int nig = WGM * nN, gid = wgid / nig, fm = gid * WGM, gsz = (nM - fm) < WGM ? (nM - fm) : WGM;
        u.pm = fm + ((wgid % nig) % gsz); u.pn = (wgid % nig) / gsz; return true;
    }
    __device__ __forceinline__ void a_ready(const Unit&) const {}
    __device__ __forceinline__ void done(const Unit&) const {}
};

__device__ __forceinline__ unsigned cvt_pk_bf16(float lo, float hi) { unsigned r; asm volatile("v_cvt_pk_bf16_f32 %0, %1, %2" : "=v"(r) : "v"(lo), "v"(hi)); return r; }
typedef float f32x2 __attribute__((ext_vector_type(2)));
template <class Epi, class Sched, bool ALIGN_EPI = false, bool SP2 = false>
__device__ __forceinline__ void gemm_phase(PG8_LAS unsigned char* lds, const Gemm g, const Sched& S, const Epi& E) {
    const int tid = threadIdx.x, wid = __builtin_amdgcn_readfirstlane(tid >> 6), lane = tid & 63, wr = wid >> 2, wc = wid & 3, fr = lane & 15, fq = lane >> 4;
    const int K = g.K, nt = K / BK;
    unsigned voffA[2], voffB[2];
#pragma unroll
    for (int i = 0; i < 2; ++i) { int R, C; stage_rc(tid * 16 + i * 8192, R, C); const int Rb = Epi::PERM ? ((R & ~31) + perm32(R & 31)) : R;
        voffA[i] = (unsigned)(R * K + C) * 2u; voffB[i] = (unsigned)(Rb * K + C) * 2u; }
    const size_t kstep = (size_t)(BK * 2);
    const size_t hstep = (size_t)HALF * K * 2;
    const size_t tstep = 2 * hstep;
    const unsigned ldsw = (unsigned)wid * 1024u;
    const int aoff = lds_byte(wr * 64 + fr, fq * 8), boff = lds_byte(wc * 32 + fr, fq * 8);
#define PG8_SA(b, h) (((b) * 2 + (h)) * HTB)
#define PG8_SB(b, h) ((4 + (b) * 2 + (h)) * HTB)
#define PG8_STAGE(bufoff, gbase, voff) do { _Pragma("unroll") for (int _i = 0; _i < 2; ++_i) \
        __builtin_amdgcn_global_load_lds((const unsigned*)((const char*)(gbase) + (voff)[_i]), (PG8_LAS unsigned*)(lds + (bufoff) + ldsw + _i * 8192), 16, 0, 0); } while (0)
#define PG8_LDA(dst, b, h) do { _Pragma("unroll") for (int m = 0; m < 4; ++m) _Pragma("unroll") for (int k = 0; k < 2; ++k) dst[m][k] = *(const PG8_LAS bf16x8*)(lds + PG8_SA(b, h) + aoff + m * 2048 + k * 1024); } while (0)
#define PG8_LDB(dst, b, h) do { _Pragma("unroll") for (int n = 0; n < 2; ++n) _Pragma("unroll") for (int k = 0; k < 2; ++k) dst[n][k] = *(const PG8_LAS bf16x8*)(lds + PG8_SB(b, h) + boff + n * 2048 + k * 1024); } while (0)
#define PG8_MMA(ai, bj, At, Bt) do { __builtin_amdgcn_s_setprio(1); _Pragma("unroll") for (int m = 0; m < 4; ++m) _Pragma("unroll") for (int n = 0; n < 2; ++n) _Pragma("unroll") for (int k = 0; k < 2; ++k) \
        acc[ai][bj][m][n] = __builtin_amdgcn_mfma_f32_16x16x32_bf16(Bt[n][k], At[m][k], acc[ai][bj][m][n], 0, 0, 0); __builtin_amdgcn_s_setprio(0); } while (0)
#define PG8_WAIT_V(n) asm volatile("s_waitcnt vmcnt(" #n ")" ::: "memory")
#define PG8_WAIT_L(n) asm volatile("s_waitcnt lgkmcnt(" #n ")" ::: "memory")
#define PG8_BAR __builtin_amdgcn_s_barrier()
#define PG8_SCHED __builtin_amdgcn_sched_barrier(0)
    Unit cur, nxt; int ui = 0;
    if (!S.next(0, cur)) return;
    f32x4 acc[2][2][4][2];
#pragma unroll
    for (int a = 0; a < 2; ++a)
#pragma unroll
        for (int b = 0; b < 2; ++b)
#pragma unroll
            for (int m = 0; m < 4; ++m)
#pragma unroll
                for (int n = 0; n < 2; ++n) acc[a][b][m][n] = (f32x4){0.f, 0.f, 0.f, 0.f};
    bf16x8 At[4][2], B0[2][2], B1[2][2];
    const char* cA = (const char*)g.A + (size_t)cur.pm * tstep; const char* cB = (const char*)g.Bt + (size_t)cur.pn * tstep;
    S.a_ready(cur);
    if constexpr (SP2) {
        PG8_STAGE(PG8_SB(0, 0), cB, voffB); PG8_STAGE(PG8_SB(0, 1), cB + hstep, voffB); PG8_STAGE(PG8_SA(0, 0), cA, voffA); PG8_STAGE(PG8_SA(0, 1), cA + hstep, voffA);
        if (wr == 1) PG8_BAR;
        PG8_WAIT_V(2); PG8_BAR;
        PG8_STAGE(PG8_SB(1, 0), cB + kstep, voffB); PG8_STAGE(PG8_SA(1, 0), cA + kstep, voffA); PG8_STAGE(PG8_SB(1, 1), cB + hstep + kstep, voffB);
        PG8_WAIT_V(6); PG8_BAR;
    } else {
        PG8_STAGE(PG8_SB(0, 0), cB, voffB); PG8_STAGE(PG8_SA(0, 0), cA, voffA); PG8_STAGE(PG8_SB(0, 1), cB + hstep, voffB); PG8_STAGE(PG8_SA(0, 1), cA + hstep, voffA);
        if (wr == 1) PG8_BAR;
        PG8_WAIT_V(4); PG8_BAR;
        PG8_STAGE(PG8_SB(1, 0), cB + kstep, voffB); PG8_STAGE(PG8_SA(1, 0), cA + kstep, voffA); PG8_STAGE(PG8_SB(1, 1), cB + hstep + kstep, voffB);
        PG8_WAIT_V(6); PG8_BAR;
    }
    for (;;) {
        const bool has_next = S.next(ui + 1, nxt);
        const char* nA = has_next ? (const char*)g.A + (size_t)nxt.pm * tstep : cA; const char* nB = has_next ? (const char*)g.Bt + (size_t)nxt.pn * tstep : cB;
        for (int t = 0; t < nt; t += 2) {
            const bool last = (t == nt - 2);
            const char* a1 = cA + (size_t)(t + 1) * kstep;
            const char* a2 = last ? nA : cA + (size_t)(t + 2) * kstep; const char* b2 = last ? nB : cB + (size_t)(t + 2) * kstep;
            const char* a3 = a2 + kstep; const char* b3 = b2 + kstep;
            if (last && has_next) S.a_ready(nxt);
            if constexpr (SP2) {
            PG8_LDB(B0, 0, 0); PG8_LDB(B1, 0, 1); PG8_SCHED; PG8_LDA(At, 0, 0); PG8_STAGE(PG8_SA(1, 1), a1 + hstep, voffA);
            PG8_WAIT_V(8); PG8_WAIT_L(0); PG8_BAR; PG8_MMA(0, 0, At, B0); PG8_MMA(0, 1, At, B1); PG8_BAR; PG8_SCHED;
            PG8_LDA(At, 0, 1); PG8_STAGE(PG8_SB(0, 0), b2, voffB); PG8_STAGE(PG8_SB(0, 1), b2 + hstep, voffB); PG8_STAGE(PG8_SA(0, 0), a2, voffA);
            PG8_WAIT_V(8); PG8_WAIT_L(0); PG8_BAR; PG8_MMA(1, 0, At, B0); PG8_MMA(1, 1, At, B1); PG8_BAR; PG8_SCHED;
            PG8_LDB(B0, 1, 0); PG8_LDB(B1, 1, 1); PG8_SCHED; PG8_LDA(At, 1, 0); PG8_STAGE(PG8_SA(0, 1), a2 + hstep, voffA);
            PG8_WAIT_V(8); PG8_WAIT_L(0); PG8_BAR; PG8_MMA(0, 0, At, B0); PG8_MMA(0, 1, At, B1); PG8_BAR; PG8_SCHED;
            PG8_LDA(At, 1, 1); PG8_STAGE(PG8_SB(1, 0), b3, voffB); PG8_STAGE(PG8_SB(1, 1), b3 + hstep, voffB); PG8_STAGE(PG8_SA(1, 0), a3, voffA);
            PG8_WAIT_V(8); PG8_WAIT_L(0); PG8_BAR; PG8_MMA(1, 0, At, B0); PG8_MMA(1, 1, At, B1); PG8_BAR; PG8_SCHED;
            } else {
            PG8_LDB(B0, 0, 0); PG8_SCHED; PG8_LDA(At, 0, 0); PG8_STAGE(PG8_SA(1, 1), a1 + hstep, voffA);
            PG8_WAIT_L(8); PG8_BAR; PG8_WAIT_L(0); PG8_MMA(0, 0, At, B0); PG8_BAR; PG8_SCHED;
            PG8_LDB(B1, 0, 1); PG8_STAGE(PG8_SB(0, 0), b2, voffB);
            PG8_BAR; PG8_WAIT_L(0); PG8_MMA(0, 1, At, B1); PG8_BAR;
            PG8_LDA(At, 0, 1); PG8_STAGE(PG8_SA(0, 0), a2, voffA);
            PG8_BAR; PG8_WAIT_L(0); PG8_MMA(1, 0, At, B0); PG8_BAR; PG8_SCHED;
            PG8_STAGE(PG8_SB(0, 1), b2 + hstep, voffB);
            PG8_WAIT_V(6); PG8_BAR; PG8_MMA(1, 1, At, B1); PG8_BAR;
            PG8_LDB(B0, 1, 0); PG8_SCHED; PG8_LDA(At, 1, 0); PG8_STAGE(PG8_SA(0, 1), a2 + hstep, voffA);
            PG8_WAIT_L(8); PG8_BAR; PG8_WAIT_L(0); PG8_MMA(0, 0, At, B0); PG8_BAR; PG8_SCHED;
            PG8_LDB(B1, 1, 1); PG8_STAGE(PG8_SB(1, 0), b3, voffB);
            PG8_BAR; PG8_WAIT_L(0); PG8_MMA(0, 1, At, B1); PG8_BAR;
            PG8_LDA(At, 1, 1); PG8_STAGE(PG8_SA(1, 0), a3, voffA);
            PG8_BAR; PG8_WAIT_L(0); PG8_MMA(1, 0, At, B0); PG8_BAR; PG8_SCHED;
            PG8_STAGE(PG8_SB(1, 1), b3 + hstep, voffB);
            PG8_WAIT_V(6); PG8_BAR; PG8_MMA(1, 1, At, B1); PG8_BAR;
            }
        }
        if constexpr (ALIGN_EPI) { if (wr == 0) PG8_BAR; }
        if constexpr (!Epi::AFTER_DRAIN) { E(acc, cur, wr, wc, fr, fq); S.done(cur); }
        if (!has_next) break;
#pragma unroll
        for (int a = 0; a < 2; ++a)
#pragma unroll
            for (int b = 0; b < 2; ++b)
#pragma unroll
                for (int m = 0; m < 4; ++m)
#pragma unroll
                    for (int n = 0; n < 2; ++n) acc[a][b][m][n] = (f32x4){0.f, 0.f, 0.f, 0.f};
        cur = nxt; cA = nA; cB = nB; ++ui;
        if constexpr (ALIGN_EPI) { if (wr == 1) PG8_BAR; }
    }
    PG8_WAIT_V(0);
    if constexpr (!ALIGN_EPI) { if (wr == 0) PG8_BAR; }
    PG8_BAR;
    if constexpr (Epi::AFTER_DRAIN) { E.fused(acc, cur, wr, wc, fr, fq, lds, wid, lane); S.done(cur); }
#undef PG8_SA
#undef PG8_SB
#undef PG8_STAGE
#undef PG8_LDA
#undef PG8_LDB
#undef PG8_MMA
#undef PG8_WAIT_V
#undef PG8_WAIT_L
#undef PG8_BAR
#undef PG8_SCHED
}
}
#define LAS __attribute__((address_space(3)))
#define XB_TMO      128
#define XB_XCNT(j)  (256  + 64 * (j))
#define XB_XSUB(j)  (1280 + 64 * (j))
#define XB_XGEN(j)  (2304 + 64 * (j))
#define XB_TOP      3328
#define XB_TOPGEN   3392
#define XCD_BAR_WORDS 3456
#define XB_SPIN_CAP (1u << 18)

__device__ __forceinline__ unsigned xb_ld(unsigned* p)              { return __hip_atomic_load(p, __ATOMIC_RELAXED, __HIP_MEMORY_SCOPE_AGENT); }
__device__ __forceinline__ unsigned xb_add(unsigned* p, unsigned v) { return __hip_atomic_fetch_add(p, v, __ATOMIC_RELAXED, __HIP_MEMORY_SCOPE_AGENT); }
__device__ __forceinline__ unsigned xb_xcc_id() { return (unsigned)__builtin_amdgcn_s_getreg((3 << 11) | 20) & 0xFu; }
#define XB_SPIN(cond, bar) do { unsigned _sp = 0; while (cond) { __builtin_amdgcn_s_sleep(1); \
    if ((++_sp & 255u) == 0u) { if (xb_ld(&(bar)[XB_TMO])) break; if (_sp > XB_SPIN_CAP) { atomicAdd(&(bar)[XB_TMO], 1u); break; } } } } while (0)

struct XcdBarrier {
    unsigned* bar; unsigned x;
    volatile LAS unsigned* st;
};

__device__ __forceinline__ XcdBarrier xcd_barrier_post(unsigned* bar, volatile LAS unsigned* st) {
    XcdBarrier b; b.bar = bar; b.x = xb_xcc_id(); b.st = st;
    if (threadIdx.x == 0) (void)xb_add(&bar[XB_XCNT(b.x)], 1u);
    return b;
}
__device__ __forceinline__ void xcd_barrier_complete(unsigned* bar, unsigned x, unsigned& nloc, unsigned& nx) {
    const unsigned G = gridDim.x * gridDim.y * gridDim.z;
    unsigned sum, cnt, mine, sp = 0u;
    for (;;) {
        sum = 0u; cnt = 0u; mine = 0u;
#pragma unroll
        for (unsigned j = 0; j < 16; ++j) { const unsigned c = xb_ld(&bar[XB_XCNT(j)]); sum += c; cnt += (c > 0u) ? 1u : 0u; mine = (j == x) ? c : mine; }
        if (sum == G) break;
        __builtin_amdgcn_s_sleep(1);
        if ((++sp & 255u) == 0u) { if (xb_ld(&bar[XB_TMO])) break; if (sp > XB_SPIN_CAP) { atomicAdd(&bar[XB_TMO], 1u); break; } }
    }
    nloc = mine > 0u ? mine : 1u; nx = cnt > 0u ? cnt : 1u;
}

__device__ __forceinline__ void xcd_barrier(const XcdBarrier& b) {
    asm volatile("s_waitcnt vmcnt(0)" ::: "memory");
    __syncthreads();
    if (threadIdx.x == 0) {
        unsigned* bar = b.bar;
        __builtin_amdgcn_s_waitcnt(0);
        unsigned nloc = b.st[0], nx = b.st[1];
        if (nloc == 0u) { xcd_barrier_complete(bar, b.x, nloc, nx); b.st[0] = nloc; b.st[1] = nx; }
        const unsigned old = xb_add(&bar[XB_XSUB(b.x)], 1u);
        const unsigned gen = old / nloc;
        if (old + 1u == (gen + 1u) * nloc) {
            __builtin_amdgcn_fence(__ATOMIC_RELEASE, "agent");
            asm volatile("s_waitcnt vmcnt(0)" ::: "memory");
            const unsigned og = xb_add(&bar[XB_TOP], 1u);
            const unsigned tg = og / nx;
            if (og + 1u == (tg + 1u) * nx) xb_add(&bar[XB_TOPGEN], 1u);
            else XB_SPIN(xb_ld(&bar[XB_TOPGEN]) == tg, bar);
            __builtin_amdgcn_fence(__ATOMIC_ACQUIRE, "agent");
            xb_add(&bar[XB_XGEN(b.x)], 1u);
            asm volatile("s_waitcnt vmcnt(0)" ::: "memory");
        } else {
            XB_SPIN(xb_ld(&bar[XB_XGEN(b.x)]) == gen, bar);
            __builtin_amdgcn_fence(__ATOMIC_ACQUIRE, "agent");
            asm volatile("s_waitcnt vmcnt(0)" ::: "memory");
        }
    }
    __syncthreads();
}

#define GAS __attribute__((address_space(1)))
#define LAS __attribute__((address_space(3)))
typedef unsigned short bf16;
typedef unsigned v4u __attribute__((ext_vector_type(4)));
typedef unsigned v2u __attribute__((ext_vector_type(2)));
typedef float f32x4 __attribute__((ext_vector_type(4)));
typedef float f32x16 __attribute__((ext_vector_type(16)));
typedef short bf16x8 __attribute__((ext_vector_type(8)));
typedef short s16x4 __attribute__((ext_vector_type(4)));
#if MK_DIAG_F32
typedef float act_t;
#else
typedef bf16 act_t;
#endif

constexpr int DM = 1024, TP = 2048, NPB = 8, NP = NPB * TP, NSB = 32, TS = 4, NS = NSB * TS, NR = NP + NS, NSEQ = NPB + NSB;
constexpr int AW = 512, INP = 4608, DFF = 2816, UPC = 5632, MODC = 6144;
constexpr int NWV = 8, NTHR = 512, NRP = NP + 256;
constexpr float EPS = 1e-6f;
constexpr float LOG2E = 1.4426950408889634f;
constexpr float QSCALE = 0.125f * LOG2E;
constexpr float NEGBIG = -1e30f;
constexpr size_t O_YP = 0, O_YS = 16777216, O_KVP = 16908288, O_KVS = 25296896, O_WINP = 25362432, O_WINS = 26411008, O_VCH = 30605312, O_CONVP = 30670848, O_CONVS = 30760960, O_END = 31121408;

constexpr size_t al4k(size_t x) { return (x + 4095) & ~(size_t)4095; }
constexpr size_t ASZ = sizeof(act_t);
constexpr size_t WS_CTL = 0, CTL_ZERO_BYTES = 1u << 20;
constexpr size_t WS_MOD = WS_CTL + CTL_ZERO_BYTES;
constexpr size_t WS_B1P = WS_MOD + al4k((size_t)NSEQ * MODC * 4);
constexpr size_t WS_W1F = WS_B1P + 4096;
constexpr size_t WS_W1L = WS_W1F + al4k((size_t)2 * 4096 * 64 * 2);
constexpr size_t WS_WSB = WS_W1L + al4k((size_t)2 * 4096 * 64 * 2);
constexpr size_t WS_QS = WS_WSB + al4k((size_t)4 * 128 * 128 * 2) - al4k((size_t)2 * 4096 * 64 * 2) + al4k((size_t)2 * 4096 * 64 * 2);
constexpr size_t WS_WIN = WS_QS + al4k((size_t)NS * 512 * 4);
constexpr size_t WS_WA = WS_WIN + al4k((size_t)INP * DM * 2);
constexpr size_t WS_WB = WS_WA + al4k((size_t)DM * AW * 2);
constexpr size_t WS_WOUT = WS_WB + al4k((size_t)DM * AW * 2);
constexpr size_t WS_WUP = WS_WOUT + al4k((size_t)DM * DM * 2);
constexpr size_t WS_WDN = WS_WUP + al4k((size_t)UPC * DM * 2);
constexpr size_t WS_KCP = WS_WDN + al4k((size_t)DM * DFF * 2);
constexpr size_t WS_VCP = WS_KCP + al4k((size_t)NPB * 32 * 128 * 4);
constexpr size_t WS_KCS = WS_VCP + al4k((size_t)NPB * 32 * 128 * 4);
constexpr size_t WS_VCS = WS_KCS + al4k((size_t)NSB * 256 * 128 * 4);
constexpr size_t WS_HN = WS_VCS + al4k((size_t)NSB * 256 * 128 * 4);
constexpr size_t WS_U = WS_HN + al4k((size_t)NRP * DM * ASZ);
constexpr size_t WS_V = WS_U + al4k((size_t)NR * AW * ASZ);
constexpr size_t WS_Q = WS_V + al4k((size_t)NR * AW * 4);
constexpr size_t WS_KVSB = WS_Q + al4k((size_t)NR * 512 * 2);
constexpr size_t WS_KVWB = WS_KVSB + al4k((size_t)NR * 256 * 2);
constexpr size_t WS_ZG = WS_KVWB + al4k((size_t)NR * 256 * 2);
constexpr size_t WS_GAB = WS_ZG + al4k((size_t)NR * 32 * 4);
constexpr size_t WS_YA = WS_GAB + al4k((size_t)NR * 2048 * ASZ);
constexpr size_t WS_YB = WS_YA + al4k((size_t)NR * 512 * ASZ);
constexpr size_t WS_MIXF = WS_YB + al4k((size_t)NR * 512 * ASZ);
constexpr size_t WS_MIX = WS_MIXF + al4k((size_t)NR * DM * 4);
constexpr size_t WS_X1 = WS_MIX + al4k((size_t)NR * DM * ASZ);
constexpr size_t WS_H2 = WS_X1 + al4k((size_t)NR * DM * 4);
constexpr size_t WS_UP = WS_H2 + al4k((size_t)NRP * DM * ASZ);
constexpr size_t WS_ACT = WS_UP + al4k((size_t)NR * UPC * ASZ);
constexpr size_t WS_X2 = WS_ACT + al4k((size_t)NR * DFF * ASZ);
constexpr size_t WS_UPS = WS_X2 + al4k((size_t)NR * DM * 4);
constexpr size_t WS_TAIL = WS_UPS + al4k((size_t)NS * UPC * 4);
constexpr size_t WS_HEAD = WS_TAIL + al4k((size_t)65 * 2 * UPC * 4);
constexpr size_t WS_PRE = WS_HEAD + al4k((size_t)65 * 2 * UPC * 4);
constexpr size_t WS_QF = WS_PRE + al4k((size_t)16 * 4 * 4096 * 4) - al4k((size_t)65 * 2 * UPC * 4) + WS_HEAD - WS_HEAD + al4k((size_t)65 * 2 * UPC * 4) - al4k((size_t)NR * DM * 4) + al4k((size_t)NR * DM * 4);
constexpr size_t WS_KVWF = WS_QF + (MK_DIAG_F32 ? al4k((size_t)NP * 512 * 4) : 0);
constexpr size_t WS_END = WS_KVWF + (MK_DIAG_F32 ? al4k((size_t)NP * 256 * 4) : 0);
constexpr int CW_BAR = 4096, CW_CMP = 8192;

constexpr int RING_BYTES = 131072, MISC_OFF = RING_BYTES + 320, LDS_BYTES = 147456;

__device__ __forceinline__ float ex2(float x) { return __builtin_amdgcn_exp2f(x); }
__device__ __forceinline__ float rcpf_(float x) { return __builtin_amdgcn_rcpf(x); }
__device__ __forceinline__ float sigmoidf_(float x) { return rcpf_(1.0f + ex2(-LOG2E * x)); }
__device__ __forceinline__ float gelu_t(float x) { const float u = x + 0.044715f * x * x * x; return x * rcpf_(1.0f + ex2(-2.3022081985f * u)); }
__device__ __forceinline__ unsigned pk2(float lo, float hi) { return pg8::cvt_pk_bf16(lo, hi); }
__device__ __forceinline__ bf16 f2bf(float f) { return (bf16)(pk2(f, 0.f) & 0xffffu); }
__device__ __forceinline__ float bf2f(bf16 b) { return __builtin_bit_cast(float, (unsigned)b << 16); }
__device__ __forceinline__ void st8_bf(bf16* p, const float* v) { v4u w; w.x = pk2(v[0], v[1]); w.y = pk2(v[2], v[3]); w.z = pk2(v[4], v[5]); w.w = pk2(v[6], v[7]); *(v4u*)p = w; }
__device__ __forceinline__ void st8_f32(float* p, const float* v) { *(f32x4*)p = (f32x4){v[0], v[1], v[2], v[3]}; *(f32x4*)(p + 4) = (f32x4){v[4], v[5], v[6], v[7]}; }
__device__ __forceinline__ void ld8_f32(const float* p, float* v) { const f32x4 a = *(const f32x4*)p, b = *(const f32x4*)(p + 4); v[0] = a[0]; v[1] = a[1]; v[2] = a[2]; v[3] = a[3]; v[4] = b[0]; v[5] = b[1]; v[6] = b[2]; v[7] = b[3]; }
__device__ __forceinline__ void ld8_bf(const bf16* p, float* v) { const v4u w = *(const v4u*)p;
    v[0] = __builtin_bit_cast(float, w.x << 16); v[1] = __builtin_bit_cast(float, w.x & 0xffff0000u); v[2] = __builtin_bit_cast(float, w.y << 16); v[3] = __builtin_bit_cast(float, w.y & 0xffff0000u);
    v[4] = __builtin_bit_cast(float, w.z << 16); v[5] = __builtin_bit_cast(float, w.z & 0xffff0000u); v[6] = __builtin_bit_cast(float, w.w << 16); v[7] = __builtin_bit_cast(float, w.w & 0xffff0000u); }
#if MK_DIAG_F32
__device__ __forceinline__ void st8_act(act_t* p, const float* v) { st8_f32(p, v); }
__device__ __forceinline__ void ld8_act(const act_t* p, float* v) { ld8_f32(p, v); }
__device__ __forceinline__ float ld_act(const act_t* p) { return *p; }
__device__ __forceinline__ void st_act(act_t* p, float v) { *p = v; }
#else
__device__ __forceinline__ void st8_act(act_t* p, const float* v) { st8_bf(p, v); }
__device__ __forceinline__ void ld8_act(const act_t* p, float* v) { ld8_bf(p, v); }
__device__ __forceinline__ float ld_act(const act_t* p) { return bf2f(*p); }
__device__ __forceinline__ void st_act(act_t* p, float v) { *p = f2bf(v); }
#endif
__device__ __forceinline__ float wave_sum(float v) {
#pragma unroll
    for (int o = 1; o < 64; o <<= 1) v += __shfl_xor(v, o);
    return v;
}
__device__ __forceinline__ float wave_max(float v) {
#pragma unroll
    for (int o = 1; o < 64; o <<= 1) v = fmaxf(v, __shfl_xor(v, o));
    return v;
}
__device__ __forceinline__ int crow(int r, int hi) { return (r & 3) + 8 * (r >> 2) + 4 * hi; }
__device__ __forceinline__ bf16x8 pack8(const f32x4 a, const f32x4 b) { v4u w; w.x = pk2(a[0], a[1]); w.y = pk2(a[2], a[3]); w.z = pk2(b[0], b[1]); w.w = pk2(b[2], b[3]); return __builtin_bit_cast(bf16x8, w); }
#define LDS_WAIT() asm volatile("s_waitcnt lgkmcnt(0)" ::: "memory")

struct Args { const void* in[30]; float* out; unsigned char* ws; int ph_lo, ph_hi, li, pad; };
struct Frame {
    LAS unsigned char* lds; int tid, lane, wave, G, bid;
    const float *x_p, *x_s, *cache, *st_win, *st_conv; const int* ptab; const float *c_p, *c_s, *w_ada, *b_ada, *g1, *w_in, *lng, *lnb, *w_sp, *b_sp, *pe, *cw1, *cb1, *cw2, *cb2, *w_a, *w_b, *w_out, *g2, *w_up, *w_conv, *b_conv, *w_dn, *g_fin;
    float* out; unsigned char* ws;
    float *UPS, *TAIL, *HEAD, *PRE; float *MOD, *B1P, *KCP, *VCP, *KCS, *VCS, *V, *ZG, *MIXF, *X1, *X2;
    float* QS; float* QF; float* KVWF; bf16 *W1L; bf16* WSB; bf16 *W1F, *WIN, *WA, *WB, *WOUT, *WUP, *WDN, *Q, *KVSB, *KVWB;
    act_t *HN, *U, *GAB, *YA, *YB, *MIX, *H2, *UP, *ACT;
};
__device__ __forceinline__ int seq_of(int row) { return row < NP ? (row >> 11) : NPB + ((row - NP) >> 2); }
__device__ __forceinline__ const float* xrow_of(const Frame& F, int row) { return row < NP ? F.x_p + (size_t)row * DM : F.x_s + (size_t)(row - NP) * DM; }

struct MapId { __device__ __forceinline__ int operator()(int n) const { return n; } };
struct MapIn { __device__ __forceinline__ int operator()(int n) const { return n < 2304 ? n : (n < 4352 ? n + 24 : (n < 4376 ? n - 4352 + 2304 : -1)); } };

struct MapUp { __device__ __forceinline__ int operator()(int n) const { const int t = n >> 8, c = n & 255; return c < 128 ? 128 * t + c : DFF + 128 * t + (c - 128); } };

template <class Fn, class Map> __device__ __forceinline__ void gemm_naive(Frame& F, const float* A, const float* W, int ldw, Map map, int M, int N, int K, const Fn& f) {
    LAS float* As = (LAS float*)F.lds;
    LAS float* Bs = As + 16 * 132;
    const int tid = F.tid, tr = tid >> 4, tc = tid & 15;
    const int nM = (M + 127) / 128, nN = N / 128, nt = nM * nN;
    for (int tile = F.bid; tile < nt; tile += F.G) {
        const int m0 = (tile / nN) * 128, n0 = (tile % nN) * 128;
        float acc[4][8];
#pragma unroll
        for (int i = 0; i < 4; ++i)
#pragma unroll
            for (int j = 0; j < 8; ++j) acc[i][j] = 0.f;
        const int arow = m0 + (tid >> 2), ak = (tid & 3) * 4;
        const int bk = tid >> 5, bn = (tid & 31) * 4; const int oc = map(n0 + bn);
        for (int k0 = 0; k0 < K; k0 += 16) {
            f32x4 av = (f32x4){0.f, 0.f, 0.f, 0.f}; if (arow < M) av = *(const f32x4*)(A + (size_t)arow * K + k0 + ak);
            f32x4 bv = (f32x4){0.f, 0.f, 0.f, 0.f}; if (oc >= 0) { const float* wp = W + (size_t)(k0 + bk) * ldw + oc; bv = (f32x4){wp[0], wp[1], wp[2], wp[3]}; }
            __syncthreads();
#pragma unroll
            for (int e = 0; e < 4; ++e) As[(ak + e) * 132 + (tid >> 2)] = av[e];
            *(LAS f32x4*)(Bs + bk * 128 + bn) = bv;
            __syncthreads();
#pragma unroll
            for (int kk = 0; kk < 16; ++kk) {
                const f32x4 a4 = *(const LAS f32x4*)(As + kk * 132 + tr * 4);
                const f32x4 b0 = *(const LAS f32x4*)(Bs + kk * 128 + tc * 8), b1 = *(const LAS f32x4*)(Bs + kk * 128 + tc * 8 + 4);
#pragma unroll
                for (int i = 0; i < 4; ++i) {
#pragma unroll
                    for (int j = 0; j < 4; ++j) { acc[i][j] += a4[i] * b0[j]; acc[i][4 + j] += a4[i] * b1[j]; } }
            }
        }
#pragma unroll
        for (int i = 0; i < 4; ++i) { const int row = m0 + tr * 4 + i; if (row < M) f(row, n0 + tc * 8, acc[i]); }
    }
    __syncthreads();
}

template <class Fn> struct Epi8 {
    static constexpr bool PERM = true, AFTER_DRAIN = false; Fn f;
    __device__ __forceinline__ void operator()(const pg8::f32x4 (&acc)[2][2][4][2], const pg8::Unit& u, int wr, int wc, int fr, int fq) const {
#pragma unroll
        for (int ai = 0; ai < 2; ++ai)
#pragma unroll
            for (int m = 0; m < 4; ++m)
#pragma unroll
                for (int bj = 0; bj < 2; ++bj) {
                    const int row = u.pm * 256 + ai * 128 + wr * 64 + m * 16 + fr, col = u.pn * 256 + bj * 128 + wc * 32 + 8 * fq;
                    float v[8]; const pg8::f32x4 a = acc[ai][bj][m][0], b = acc[ai][bj][m][1];
                    v[0] = a[0]; v[1] = a[1]; v[2] = a[2]; v[3] = a[3]; v[4] = b[0]; v[5] = b[1]; v[6] = b[2]; v[7] = b[3];
                    if (row < NR) f(row, col, v); }
    }
};
template <class Fn> __device__ __forceinline__ void sample_gemm(Frame& F, const bf16* A, const bf16* Bt, int K, int nvalid, const Fn& f) {
    const int lane = F.lane, r32 = lane & 31, hi = lane >> 5, w = F.wave;
    LAS float* slab = (LAS float*)F.lds + w * 4096;
    const int nu = (nvalid + 31) / 32, ksw = K / 128;
    for (int u = F.G - 1 - F.bid; u < nu; u += F.G) {
        const int n0 = 32 * u;
        f32x16 acc[4];
#pragma unroll
        for (int mb = 0; mb < 4; ++mb) acc[mb] = (f32x16){};
        const bf16* bp = Bt + (size_t)(n0 + r32) * K + (size_t)w * ksw * 16 + 8 * hi; const bf16* ap = A + (size_t)r32 * K + (size_t)w * ksw * 16 + 8 * hi;
#pragma unroll 4
        for (int ks = 0; ks < ksw; ++ks) {
            const bf16x8 b = *(const bf16x8*)(bp + 16 * ks);
#pragma unroll
            for (int mb = 0; mb < 4; ++mb) { const bf16x8 a = *(const bf16x8*)(ap + (size_t)(32 * mb) * K + 16 * ks); acc[mb] = __builtin_amdgcn_mfma_f32_32x32x16_bf16(a, b, acc[mb], 0, 0, 0); }
        }
#pragma unroll
        for (int mb = 0; mb < 4; ++mb)
#pragma unroll
            for (int r = 0; r < 16; ++r) slab[(32 * mb + crow(r, hi)) * 32 + r32] = acc[mb][r];
        __syncthreads();
        { const int m = F.tid >> 2, c8 = (F.tid & 3) * 8; float v[8];
#pragma unroll
          for (int e = 0; e < 8; ++e) v[e] = 0.f;
#pragma unroll
          for (int ww = 0; ww < NWV; ++ww) { const LAS float* sp = (const LAS float*)F.lds + ww * 4096 + m * 32 + c8; const f32x4 x0 = *(const LAS f32x4*)sp, x1 = *(const LAS f32x4*)(sp + 4);
              v[0] += x0[0]; v[1] += x0[1]; v[2] += x0[2]; v[3] += x0[3]; v[4] += x1[0]; v[5] += x1[1]; v[6] += x1[2]; v[7] += x1[3]; }
          if (n0 + c8 < nvalid) f(NP + m, n0 + c8, v); }
        __syncthreads();
    }
}
template <bool FOLD, class Fn, class Map> __device__ __forceinline__ void run_gemm(Frame& F, const act_t* A, const float* W, int ldw, Map map, const bf16* Bt, int N, int K, int nvalid, const Fn& f) {
#if MK_DIAG_F32
    gemm_naive(F, A, W, ldw, map, NR, N, K, f);
#else
    { pg8::Gemm g{A, Bt, FOLD ? NRP : NP, N, K}; pg8::StaticOrder S; S.init(FOLD ? NRP : NP, N, F.G, F.bid); Epi8<Fn> E{f};
      pg8::gemm_phase<Epi8<Fn>, pg8::StaticOrder, true, true>(F.lds, g, S, E); }
    if (!FOLD) sample_gemm(F, A + (size_t)NP * K, Bt, K, nvalid, f);
#endif
}

struct EpiIn {
    unsigned char* ws; float* out;
    __device__ __forceinline__ void operator()(int row, int c0, const float* v) const {
        act_t* const U = (act_t*)(ws + WS_U); float* const V = (float*)(ws + WS_V); bf16* const Q = (bf16*)(ws + WS_Q); float* const QF = (float*)(ws + WS_QF); float* const KVWF = (float*)(ws + WS_KVWF); float* const QS = (float*)(ws + WS_QS);
        bf16* const KVSB = (bf16*)(ws + WS_KVSB); bf16* const KVWB = (bf16*)(ws + WS_KVWB); float* const ZG = (float*)(ws + WS_ZG); act_t* const GAB = (act_t*)(ws + WS_GAB);
        float o[8];
        if (c0 < 1024) {
#pragma unroll
            for (int e = 0; e < 8; ++e) o[e] = gelu_t(v[e]);
            if (c0 < 512) st8_act(U + (size_t)row * 512 + c0, o); else st8_f32(V + (size_t)row * 512 + (c0 - 512), o);
        } else if (c0 < 1536) {
#pragma unroll
            for (int e = 0; e < 8; ++e) o[e] = v[e] * QSCALE;
            if (row < NP) { st8_bf(Q + (size_t)row * 512 + (c0 - 1024), o); if (MK_DIAG_F32) st8_f32(QF + (size_t)row * 512 + (c0 - 1024), o); } else st8_f32(QS + (size_t)(row - NP) * 512 + (c0 - 1024), o);
        } else if (c0 < 2304) {
            const int j = c0 - 1536;
            if (j < 512) {
                float* op = (row < NP ? out + O_KVP + (size_t)row * 512 : out + O_KVS + (size_t)(row - NP) * 512) + j; st8_f32(op, v);
                if (j >= 256) st8_bf(KVSB + (size_t)row * 256 + (j - 256), v);
            } else {
                const int j2 = j - 512; st8_bf(KVWB + (size_t)row * 256 + j2, v); if (MK_DIAG_F32 && row < NP) st8_f32(KVWF + (size_t)row * 256 + j2, v);
                if (row < NP) { const int t = row & (TP - 1); if (t >= TP - 512) st8_f32(out + O_WINP + ((size_t)(row >> 11) * 512 + (t - (TP - 512))) * 256 + j2, v); }
                else { const int rs = row - NP; st8_f32(out + O_WINS + ((size_t)(rs >> 2) * 512 + 508 + (rs & 3)) * 256 + j2, v); }
            }
        } else if (c0 < 4352) {
#pragma unroll
            for (int e = 0; e < 8; ++e) o[e] = sigmoidf_(v[e]);
            st8_act(GAB + (size_t)row * 2048 + (c0 - 2304), o);
        } else if (c0 < 4376) {
#pragma unroll
            for (int e = 0; e < 8; ++e) o[e] = sigmoidf_(v[e]);
            st8_f32(ZG + (size_t)row * 32 + (c0 - 4352), o);
        }
    }
};
struct EpiBrA { float* MIXF; const act_t* GAB; __device__ __forceinline__ void operator()(int row, int c0, const float* v) const {
    float g[8], o[8]; ld8_act(GAB + (size_t)row * 2048 + c0, g);
#pragma unroll
    for (int e = 0; e < 8; ++e) o[e] = g[e] * v[e];
    st8_f32(MIXF + (size_t)row * DM + c0, o); } };
struct EpiBrB { const float* MIXF; const act_t* GAB; act_t* MIX; __device__ __forceinline__ void operator()(int row, int c0, const float* v) const {
    float g[8], a[8], o[8]; ld8_act(GAB + (size_t)row * 2048 + 1024 + c0, g); ld8_f32(MIXF + (size_t)row * DM + c0, a);
#pragma unroll
    for (int e = 0; e < 8; ++e) o[e] = a[e] + g[e] * v[e];
    st8_act(MIX + (size_t)row * DM + c0, o); } };
struct EpiRes {
    const float* xp; const float* xs; const float* MOD; int goff; float* Xo;
    __device__ __forceinline__ void operator()(int row, int c0, const float* v) const {
        const float* xr = (row < NP ? xp + (size_t)row * DM : xs + (size_t)(row - NP) * DM) + c0; float a[8], g[8], o[8]; ld8_f32(xr, a); ld8_f32(MOD + (size_t)seq_of(row) * MODC + goff + c0, g);
#pragma unroll
        for (int e = 0; e < 8; ++e) o[e] = a[e] + g[e] * v[e];
        st8_f32(Xo + (size_t)row * DM + c0, o); } };
struct EpiUp { act_t* UP; float* out; __device__ __forceinline__ void operator()(int row, int c0, const float* v) const {
    st8_act(UP + (size_t)row * UPC + c0, v);
    if (row < NP) { const int t = row & (TP - 1); if (t >= TP - 2) st8_f32(out + O_CONVP + ((size_t)(row >> 11) * 2 + (t - (TP - 2))) * UPC + c0, v); }
    else { const int rs = row - NP, t = rs & 3; if (t >= 2) st8_f32(out + O_CONVS + ((size_t)(rs >> 2) * 2 + (t - 2)) * UPC + c0, v); } } };


#if !MK_DIAG_F32
template <int CTRL> __device__ __forceinline__ float dppf(float x) { return __builtin_bit_cast(float, __builtin_amdgcn_update_dpp(0, __builtin_bit_cast(int, x), CTRL, 0xf, 0xf, false)); }
struct EpiUpConv {
    static constexpr bool PERM = true, AFTER_DRAIN = false;
    unsigned char* ws; float* out; const float* w_conv; const float* b_conv; LAS float* T;
    __device__ __forceinline__ void operator()(const pg8::f32x4 (&acc)[2][2][4][2], const pg8::Unit& u, int wr, int wc, int fr, int fq) const {
        act_t* const ACT = (act_t*)(ws + WS_ACT); float* const UPS = (float*)(ws + WS_UPS); float* const TAIL = (float*)(ws + WS_TAIL); float* const HEAD = (float*)(ws + WS_HEAD);
        const int jj = 32 * wc + 8 * fq, nc0 = u.pn * 256, j = 128 * u.pn + jj;
        if (u.pm == NP / 256) {
#pragma unroll
            for (int ai = 0; ai < 2; ++ai)
#pragma unroll
                for (int m = 0; m < 4; ++m) { const int row = ai * 128 + wr * 64 + m * 16 + fr; if (row < NS) {
#pragma unroll
                    for (int bj = 0; bj < 2; ++bj) { *(f32x4*)(UPS + (size_t)row * UPC + nc0 + bj * 128 + jj) = acc[ai][bj][m][0]; *(f32x4*)(UPS + (size_t)row * UPC + nc0 + bj * 128 + jj + 4) = acc[ai][bj][m][1]; } } }
            return;
        }
        if (fr >= 14) {
#pragma unroll
            for (int ai = 0; ai < 2; ++ai)
#pragma unroll
                for (int bj = 0; bj < 2; ++bj) { LAS float* tp = T + ((ai * 2 + wr) * 2 + (fr - 14)) * 256 + bj * 128 + jj; *(LAS f32x4*)tp = acc[ai][bj][3][0]; *(LAS f32x4*)(tp + 4) = acc[ai][bj][3][1]; }
            if (wr == 1) {
#pragma unroll
                for (int bj = 0; bj < 2; ++bj) { float* gp = TAIL + ((size_t)u.pm * 2 + (fr - 14)) * UPC + nc0 + bj * 128 + jj; *(f32x4*)gp = acc[1][bj][3][0]; *(f32x4*)(gp + 4) = acc[1][bj][3][1];
                    if ((u.pm & 7) == 7) { float* op = out + O_CONVP + ((size_t)(u.pm >> 3) * 2 + (fr - 14)) * UPC + bj * DFF + j; *(f32x4*)op = acc[1][bj][3][0]; *(f32x4*)(op + 4) = acc[1][bj][3][1]; } } }
        }
        if (fr < 2 && wr == 0) {
#pragma unroll
            for (int bj = 0; bj < 2; ++bj) { float* gp = HEAD + ((size_t)u.pm * 2 + fr) * UPC + nc0 + bj * 128 + jj; *(f32x4*)gp = acc[0][bj][0][0]; *(f32x4*)(gp + 4) = acc[0][bj][0][1]; } }
        asm volatile("s_waitcnt lgkmcnt(0)" ::: "memory"); __builtin_amdgcn_s_barrier(); asm volatile("" ::: "memory");
        const bool seq_start = (u.pm & 7) == 0;
#pragma unroll
        for (int nh = 0; nh < 2; ++nh) {
            asm volatile("" ::: "memory");
            const int jc = j + 4 * nh;
            const f32x4 w0a = *(const f32x4*)(w_conv + jc), w1a = *(const f32x4*)(w_conv + UPC + jc), w2a = *(const f32x4*)(w_conv + 2 * UPC + jc), ba = *(const f32x4*)(b_conv + jc);
            const f32x4 w0g = *(const f32x4*)(w_conv + DFF + jc), w1g = *(const f32x4*)(w_conv + UPC + DFF + jc), w2g = *(const f32x4*)(w_conv + 2 * UPC + DFF + jc), bg = *(const f32x4*)(b_conv + DFF + jc);
#pragma unroll
            for (int ai = 0; ai < 2; ++ai) {
                f32x4 p1a, p2a, p1g, p2g;
                if (ai == 0 && wr == 0) { p1a = (f32x4){0.f, 0.f, 0.f, 0.f}; p2a = p1a; p1g = p1a; p2g = p1a; }
                else { const int pai = wr == 1 ? ai : ai - 1, pwr = wr == 1 ? 0 : 1; const LAS float* t14 = T + ((pai * 2 + pwr) * 2 + 0) * 256 + jj + 4 * nh; const LAS float* t15 = t14 + 256;
                    const f32x4 a15 = *(const LAS f32x4*)t15, a14 = *(const LAS f32x4*)t14, g15 = *(const LAS f32x4*)(t15 + 128), g14 = *(const LAS f32x4*)(t14 + 128);
                    p1a = a15; p1g = g15; p2a = fr == 1 ? a15 : a14; p2g = fr == 1 ? g15 : g14; }
#pragma unroll
                for (int m = 0; m < 4; ++m) { float o[4];
#pragma unroll
                    for (int e = 0; e < 4; ++e) { const float a = acc[ai][0][m][nh][e], g = acc[ai][1][m][nh][e];
                        const float r1a = dppf<0x121>(a), r2a = dppf<0x122>(a), r1g = dppf<0x121>(g), r2g = dppf<0x122>(g);
                        const float u1a = fr >= 1 ? r1a : p1a[e], u2a = fr >= 2 ? r2a : p2a[e], u1g = fr >= 1 ? r1g : p1g[e], u2g = fr >= 2 ? r2g : p2g[e];
                        const float ca = ba[e] + w0a[e] * u2a + w1a[e] * u1a + w2a[e] * a, cg = bg[e] + w0g[e] * u2g + w1g[e] * u1g + w2g[e] * g;
                        o[e] = gelu_t(ca) * cg; p1a[e] = r1a; p2a[e] = r2a; p1g[e] = r1g; p2g[e] = r2g; }
                    const bool skip = ai == 0 && wr == 0 && m == 0 && fr < 2 && !seq_start;
                    if (!skip) { act_t* op = ACT + (size_t)(u.pm * 256 + ai * 128 + wr * 64 + m * 16 + fr) * DFF + jc;
#if MK_DIAG_F32
                        *(f32x4*)op = (f32x4){o[0], o[1], o[2], o[3]};
#else
                        v2u wv; wv.x = pk2(o[0], o[1]); wv.y = pk2(o[2], o[3]); *(v2u*)op = wv;
#endif
                    } }
            }
        }
    }
};
#endif

__device__ __forceinline__ void p0_mod(Frame& F) {
    const int col0 = 32 * F.bid, w = F.wave, lane = F.lane, col = lane & 31, kh = lane >> 5;
    LAS float* sc = (LAS float*)F.lds + w * (64 * 40);
    float acc[40];
#pragma unroll
    for (int s = 0; s < 40; ++s) acc[s] = 0.f;
    for (int half = 0; half < 2; ++half) {
        const int kbase = w * 128 + half * 64;
#pragma unroll 8
        for (int s = 0; s < 40; ++s) { const float* cp = s < NPB ? F.c_p + (size_t)s * DM : F.c_s + (size_t)(s - NPB) * DM; const float c = cp[kbase + lane]; sc[lane * 40 + s] = c * sigmoidf_(c); }
        LDS_WAIT();
        for (int i = 0; i < 32; ++i) { const int kk = 2 * i + kh; const float wv = F.w_ada[(size_t)(kbase + kk) * MODC + col0 + col];
#pragma unroll
            for (int s4 = 0; s4 < 10; ++s4) { const f32x4 c4 = *(const LAS f32x4*)(sc + kk * 40 + 4 * s4);
#pragma unroll
                for (int e = 0; e < 4; ++e) acc[4 * s4 + e] += wv * c4[e]; } }
        LDS_WAIT();
    }
    __syncthreads();
    LAS float* red = (LAS float*)F.lds;
#pragma unroll
    for (int s = 0; s < 40; ++s) red[(w * 40 + s) * 64 + lane] = acc[s];
    __syncthreads();
    for (int idx = F.tid; idx < 40 * 32; idx += NTHR) { const int s = idx >> 5, c = idx & 31; float t = F.b_ada[col0 + c];
        for (int ww = 0; ww < NWV; ++ww) t += red[(ww * 40 + s) * 64 + c] + red[(ww * 40 + s) * 64 + 32 + c];
        F.MOD[(size_t)s * MODC + col0 + c] = t; }
    __syncthreads();
}
template <class Map> __device__ __forceinline__ void p0_transpose_item(const float* W, int K, int ldw, Map map, bf16* WT, LAS float* scr, int item, int nblk, int lane) {
    const int kb = item / nblk, nb = item % nblk, k0 = 64 * kb, n0 = 32 * nb; const int oc = map(n0 + (lane & 31));
#pragma unroll 8
    for (int i = 0; i < 32; ++i) { const int kk = 2 * i + (lane >> 5); scr[kk * 33 + (lane & 31)] = oc >= 0 ? W[(size_t)(k0 + kk) * ldw + oc] : 0.f; }
    LDS_WAIT(); asm volatile("" ::: "memory");
    const int c = lane & 7;
#pragma unroll
    for (int j = 0; j < 4; ++j) { const int n = (lane >> 3) + 8 * j; const LAS float* s = scr + (8 * c) * 33 + n;
        v4u o; o.x = pk2(s[0 * 33], s[1 * 33]); o.y = pk2(s[2 * 33], s[3 * 33]); o.z = pk2(s[4 * 33], s[5 * 33]); o.w = pk2(s[6 * 33], s[7 * 33]);
        *(v4u*)(WT + (size_t)(n0 + n) * K + k0 + 8 * c) = o; }
    LDS_WAIT(); asm volatile("" ::: "memory");
}
__device__ __forceinline__ void p0_prologue(Frame& F) {
    if (F.bid < 192) p0_mod(F);
    if (F.bid == F.G - 1) {
        const int slot = F.tid >> 8, kp = (F.tid >> 6) & 3, hid = F.tid & 63; float s = 0.f;
        const float* pe = F.pe + (size_t)slot * 4096 + kp * 1024; const float* w1 = F.cw1 + ((size_t)slot * 4096 + kp * 1024) * 64 + hid;
        for (int k = 0; k < 1024; ++k) s += pe[k] * w1[(size_t)k * 64];
        LAS float* r = (LAS float*)F.lds; r[F.tid] = s; __syncthreads();
        if (F.tid < 128) { const int sl = F.tid >> 6, h = F.tid & 63; F.B1P[F.tid] = F.cb1[F.tid] + r[sl * 256 + h] + r[sl * 256 + 64 + h] + r[sl * 256 + 128 + h] + r[sl * 256 + 192 + h]; }
        __syncthreads();
    }
#if !MK_DIAG_F32
    {
        LAS float* scr = (LAS float*)F.lds + F.wave * (64 * 33);
        const int gw = F.bid * NWV + F.wave, NGW = F.G * NWV;
        constexpr int I_IN = (DM / 64) * (INP / 32), I_A = (AW / 64) * (DM / 32), I_O = (DM / 64) * (DM / 32), I_UP = (DM / 64) * (UPC / 32), I_DN = (DFF / 64) * (DM / 32);
        constexpr int NITEMS = I_IN + 2 * I_A + I_O + I_UP + I_DN;
        for (int it = gw; it < NITEMS; it += NGW) {
            int r = it;
            if (r < I_IN) { p0_transpose_item(F.w_in, DM, 4376, MapIn(), F.WIN, scr, r, INP / 32, F.lane); continue; } r -= I_IN;
            if (r < I_A) { p0_transpose_item(F.w_a, AW, DM, MapId(), F.WA, scr, r, DM / 32, F.lane); continue; } r -= I_A;
            if (r < I_A) { p0_transpose_item(F.w_b, AW, DM, MapId(), F.WB, scr, r, DM / 32, F.lane); continue; } r -= I_A;
            if (r < I_O) { p0_transpose_item(F.w_out, DM, DM, MapId(), F.WOUT, scr, r, DM / 32, F.lane); continue; } r -= I_O;
            if (r < I_UP) { p0_transpose_item(F.w_up, DM, UPC, MapUp(), F.WUP, scr, r, UPC / 32, F.lane); continue; } r -= I_UP;
            p0_transpose_item(F.w_dn, DFF, DM, MapId(), F.WDN, scr, r, DM / 32, F.lane);
        }
    }
#endif
    for (int idx = F.bid * NTHR + F.tid; idx < 4 * 128 * 128 / 8; idx += F.G * NTHR) { const int e0 = idx * 8, t = (e0 >> 7) & 127, s0 = e0 & 127; float v[8]; ld8_f32(F.w_sp + e0, v);
#pragma unroll
        for (int e = 0; e < 8; ++e) if (s0 + e > t) v[e] = 0.f;
        st8_bf(F.WSB + e0, v); }
    for (int idx = F.bid * NTHR + F.tid; idx < 65536; idx += F.G * NTHR) {
        const int lane = idx & 63, nb = (idx >> 6) & 1, ks = (idx >> 7) & 3, i = (idx >> 9) & 63, slot = idx >> 15;
        const float* src = F.cw1 + (((size_t)slot * 64 + i) * 64 + 16 * ks + 8 * (lane >> 5)) * 64 + 32 * nb + (lane & 31);
        float hv[8], lv[8];
#pragma unroll
        for (int e = 0; e < 8; ++e) { const float x = src[e * 64]; const float xh = bf2f(f2bf(x)); hv[e] = xh; lv[e] = x - xh; }
        st8_bf(F.W1F + (size_t)idx * 8, hv); st8_bf(F.W1L + (size_t)idx * 8, lv);
    }
}

template <bool MODU, int NRW, class OT> __device__ __forceinline__ void rms_rows(const float* const (&xr)[NRW], const float* g, const float* const (&shift)[NRW], const float* const (&scale)[NRW], OT* const (&orow)[NRW], int lane) {
    f32x4 v[NRW][4]; float ss[NRW];
#pragma unroll
    for (int r = 0; r < NRW; ++r) {
#pragma unroll
        for (int j = 0; j < 4; ++j) v[r][j] = *(const f32x4*)(xr[r] + 4 * lane + 256 * j); }
#pragma unroll
    for (int r = 0; r < NRW; ++r) { ss[r] = 0.f;
#pragma unroll
        for (int j = 0; j < 4; ++j) ss[r] += (v[r][j][0] * v[r][j][0] + v[r][j][1] * v[r][j][1]) + (v[r][j][2] * v[r][j][2] + v[r][j][3] * v[r][j][3]); }
#pragma unroll
    for (int o = 1; o < 64; o <<= 1) {
#pragma unroll
        for (int r = 0; r < NRW; ++r) ss[r] += __shfl_xor(ss[r], o); }
#pragma unroll
    for (int r = 0; r < NRW; ++r) { const float rr = 1.0f / sqrtf(ss[r] * (1.0f / DM) + EPS);
#pragma unroll
        for (int j = 0; j < 4; ++j) { const int c = 4 * lane + 256 * j; const f32x4 gv = *(const f32x4*)(g + c); f32x4 y = v[r][j] * rr * gv;
            if (MODU) { const f32x4 sc = *(const f32x4*)(scale[r] + c), sh = *(const f32x4*)(shift[r] + c); y = y * (sc + 1.0f) + sh; }
            if (sizeof(OT) == 4) *(f32x4*)((float*)orow[r] + c) = y; else { v2u w; w.x = pk2(y[0], y[1]); w.y = pk2(y[2], y[3]); *(v2u*)((bf16*)orow[r] + c) = w; } } }
}

template <int MB, int NPOS, bool PARTIAL, class BaseFn> __device__ __forceinline__ void compress_unit(Frame& F, const BaseFn& basefn, int pos0, float* KCo, float* VCo, float* pre, int kq, unsigned* cnt) {
    const int tid = F.tid, w = F.wave, lane = F.lane, r32 = lane & 31, hi = lane >> 5, slot = w >> 2, mb = (w >> 1) & 1, nb = w & 1;
    constexpr int ABUF = 2 * 64 * 72;
    LAS bf16* AH = (LAS bf16*)F.lds; LAS bf16* AL = AH + 2 * ABUF; LAS float* red = (LAS float*)(F.lds + 4 * ABUF * 2);
    const int nl = tid >> 4, q = tid & 15; const bool stg = nl < 16 * MB; const float* sp = basefn(stg ? nl : 0) + q * 4;
    f32x4 ar[4][4]; bf16x8 bh[3][4];
#define CMP_LOADA(i, R) do { _Pragma("unroll") for (int k = 0; k < 4; ++k) ar[R][k] = stg ? *(const f32x4*)(sp + (size_t)(pos0 + (i)) * 512 + 64 * k) : (f32x4){0.f, 0.f, 0.f, 0.f}; } while (0)
#define CMP_WRITEA(buf, R) do { if (stg) { _Pragma("unroll") for (int k = 0; k < 4; ++k) { const int idx = (buf) * ABUF + ((k >> 1) * 64 + nl * 2 + (k & 1)) * 72 + 4 * q; \
        const unsigned h0 = pk2(ar[R][k][0], ar[R][k][1]), h1 = pk2(ar[R][k][2], ar[R][k][3]); \
        const float r0 = ar[R][k][0] - __builtin_bit_cast(float, h0 << 16), r1 = ar[R][k][1] - __builtin_bit_cast(float, h0 & 0xffff0000u), r2 = ar[R][k][2] - __builtin_bit_cast(float, h1 << 16), r3 = ar[R][k][3] - __builtin_bit_cast(float, h1 & 0xffff0000u); \
        v2u hv; hv.x = h0; hv.y = h1; *(LAS v2u*)(AH + idx) = hv; v2u lv; lv.x = pk2(r0, r1); lv.y = pk2(r2, r3); *(LAS v2u*)(AL + idx) = lv; } } } while (0)
#define CMP_LOADB(i, R) do { _Pragma("unroll") for (int ks = 0; ks < 4; ++ks) { const size_t bo = ((((size_t)slot * 64 + pos0 + (i)) * 4 + ks) * 2 + nb) * 512 + lane * 8; bh[R][ks] = *(const bf16x8*)(F.W1F + bo); } } while (0)
#define CMP_STEP(i, RA, RB) do { \
        if ((i) + 2 < NPOS) CMP_LOADB((i) + 2, ((RB) + 2) % 3); \
        if ((i) + 4 < NPOS) CMP_LOADA((i) + 4, RA); \
        if (mb < MB) { const LAS bf16* ah = AH + ((i) & 1) * ABUF + (slot * 64 + 32 * mb + r32) * 72 + 8 * hi; const LAS bf16* al = AL + ((i) & 1) * ABUF + (slot * 64 + 32 * mb + r32) * 72 + 8 * hi; \
            _Pragma("unroll") for (int ks = 0; ks < 4; ++ks) { const bf16x8 a = *(const LAS bf16x8*)(ah + 16 * ks), a2 = *(const LAS bf16x8*)(al + 16 * ks); \
                acc = __builtin_amdgcn_mfma_f32_32x32x16_bf16(a, bh[RB][ks], acc, 0, 0, 0); acc = __builtin_amdgcn_mfma_f32_32x32x16_bf16(a2, bh[RB][ks], acc, 0, 0, 0); } } \
        if ((i) + 1 < NPOS) CMP_WRITEA(((i) + 1) & 1, ((RA) + 1) & 3); \
        __syncthreads(); } while (0)
    f32x16 acc = (f32x16){};
    CMP_LOADB(0, 0); CMP_LOADA(0, 0); CMP_LOADB(1, 1); CMP_LOADA(1, 1); CMP_LOADA(2, 2); CMP_LOADA(3, 3); CMP_WRITEA(0, 0);
    __syncthreads();
    static_assert((NPOS - 4) % 12 == 0, "compress_unit: NPOS = 12 k + 4");
    for (int i = 0; i < NPOS - 4; i += 12) { CMP_STEP(i, 0, 0); CMP_STEP(i + 1, 1, 1); CMP_STEP(i + 2, 2, 2); CMP_STEP(i + 3, 3, 0); CMP_STEP(i + 4, 0, 1); CMP_STEP(i + 5, 1, 2);
                                             CMP_STEP(i + 6, 2, 0); CMP_STEP(i + 7, 3, 1); CMP_STEP(i + 8, 0, 2); CMP_STEP(i + 9, 1, 0); CMP_STEP(i + 10, 2, 1); CMP_STEP(i + 11, 3, 2); }
    CMP_STEP(NPOS - 4, 0, 0); CMP_STEP(NPOS - 3, 1, 1); CMP_STEP(NPOS - 2, 2, 2); CMP_STEP(NPOS - 1, 3, 0);
#undef CMP_STEP
#undef CMP_LOADA
#undef CMP_WRITEA
#undef CMP_LOADB
    if (PARTIAL) {
        static_assert(!PARTIAL || MB == 1, "partial mode: 32 rows per slot");
        if (mb < MB) {
#pragma unroll
            for (int r = 0; r < 16; ++r) __hip_atomic_store(pre + (size_t)kq * 4096 + (slot * 32 + crow(r, hi)) * 64 + 32 * nb + r32, acc[r], __ATOMIC_RELAXED, __HIP_MEMORY_SCOPE_AGENT); }
        asm volatile("s_waitcnt vmcnt(0)" ::: "memory");
        __syncthreads();
        LAS unsigned* flag = (LAS unsigned*)(F.lds + RING_BYTES + 512);
        if (F.tid == 0) *flag = __hip_atomic_fetch_add(cnt, 1u, __ATOMIC_RELAXED, __HIP_MEMORY_SCOPE_AGENT);
        __syncthreads();
        const bool last = *flag == 3u;
        __syncthreads();
        if (!last) return;
        __builtin_amdgcn_fence(__ATOMIC_ACQUIRE, "agent"); asm volatile("s_waitcnt vmcnt(0)" ::: "memory");
        for (int e = F.tid; e < 4096; e += NTHR) { const int sl = e >> 11, m = (e >> 6) & 31, hid = e & 63; const float sum = (pre[e] + pre[4096 + e]) + (pre[8192 + e] + pre[12288 + e]);
            red[(sl * 64 + m) * 64 + hid] = gelu_t(sum + F.B1P[sl * 64 + hid]); }
        __syncthreads();
    } else {
    if (mb < MB) {
#pragma unroll
        for (int r = 0; r < 16; ++r) red[(slot * 64 + 32 * mb + crow(r, hi)) * 64 + 32 * nb + r32] = acc[r]; }
    __syncthreads();
    for (int e = F.tid; e < 8192; e += NTHR) if (((e >> 6) & 63) < 32 * MB) red[e] = gelu_t(red[e] + F.B1P[(e >> 12) * 64 + (e & 63)]);
    __syncthreads();
    }
    { const int e = F.tid & 63, grp = F.tid >> 6;
      for (int it = 0; it < 16; ++it) { const int sm = it * 8 + grp, sl = sm >> 6, m = sm & 63; if (m >= 32 * MB) continue; float s = F.cb2[sl * 64 + e];
          const float* w2 = F.cw2 + (size_t)sl * 4096 + e; const LAS float* hp = red + sm * 64;
#pragma unroll 8
          for (int h = 0; h < 64; ++h) s += hp[h] * w2[h * 64];
          (sl ? VCo : KCo)[(size_t)m * 64 + e] = s; } }
    __syncthreads();
}
struct BaseSample { const float* cache; const int* pt; int n0; __device__ __forceinline__ const float* operator()(int nl) const { const int n = n0 + nl; return cache + ((size_t)pt[n >> 1] * 128 + (n & 1) * 64) * 512; } };
struct BasePrompt { const float* kv; __device__ __forceinline__ const float* operator()(int nl) const { return kv + (size_t)nl * 64 * 512; } };

__device__ __forceinline__ void gating_chunk(Frame& F, int chunk, int half) {
    constexpr int VS = 132;
    const int w = F.wave, lane = F.lane, r32 = lane & 31, hi = lane >> 5, row0 = chunk * 128;
    LAS bf16* VNT = (LAS bf16*)F.lds;
    LAS float* stg = (LAS float*)(F.lds + 256 * VS * 2) + w * (32 * 33);
#pragma unroll 1
    for (int bt = 0; bt < 2; ++bt) {
        float x[8][8];
#pragma unroll
        for (int rr = 0; rr < 8; ++rr) { const float* vr = F.V + (size_t)(row0 + 16 * w + 8 * bt + rr) * 512;
#pragma unroll
            for (int j = 0; j < 8; ++j) x[rr][j] = vr[lane + 64 * j]; }
#pragma unroll
        for (int rr = 0; rr < 8; ++rr) { float sm = 0.f;
#pragma unroll
            for (int j = 0; j < 8; ++j) sm += x[rr][j];
            const float mean = wave_sum(sm) * (1.0f / 512.0f); float qq = 0.f;
#pragma unroll
            for (int j = 0; j < 8; ++j) { const float d = x[rr][j] - mean; qq += d * d; }
            const float rstd = 1.0f / sqrtf(wave_sum(qq) * (1.0f / 512.0f) + EPS); const int sidx = 16 * w + 8 * bt + rr;
#pragma unroll
            for (int j = 0; j < 4; ++j) { const int cl = lane + 64 * j, c = half * 256 + cl; const float xv = half ? x[rr][4 + j] : x[rr][j]; VNT[cl * VS + sidx] = f2bf((xv - mean) * rstd * F.lng[c] + F.lnb[c]); } }
    }
    __syncthreads();
    const int gl = w >> 2, db = w & 3, g = half * 2 + gl;
    f32x16 acc[4];
#pragma unroll
    for (int tb = 0; tb < 4; ++tb) acc[tb] = (f32x16){};
    const bf16* Wg = F.WSB + (size_t)g * 128 * 128 + (size_t)r32 * 128 + 8 * hi;
#pragma unroll
    for (int ks = 0; ks < 8; ++ks) {
        const LAS bf16* bp = VNT + (gl * 128 + 32 * db + r32) * VS + 16 * ks + 8 * hi;
        const v2u b0 = *(const LAS v2u*)bp, b1 = *(const LAS v2u*)(bp + 4); v4u bw; bw.x = b0.x; bw.y = b0.y; bw.z = b1.x; bw.w = b1.y; const bf16x8 bfr = __builtin_bit_cast(bf16x8, bw);
#pragma unroll
        for (int tb = 0; tb < 4; ++tb) if (ks <= 2 * tb + 1) acc[tb] = __builtin_amdgcn_mfma_f32_32x32x16_bf16(*(const bf16x8*)(Wg + (size_t)(32 * tb) * 128 + 16 * ks), bfr, acc[tb], 0, 0, 0);
    }
    const int c0 = g * 128 + 32 * db;
#pragma unroll
    for (int tb = 0; tb < 4; ++tb) {
#pragma unroll
        for (int r = 0; r < 16; ++r) { const int tl = crow(r, hi); stg[tl * 33 + r32] = acc[tb][r] + F.b_sp[g * 128 + 32 * tb + tl]; }
        LDS_WAIT();
#pragma unroll
        for (int it = 0; it < 2; ++it) { const int tl = (lane >> 2) + 16 * it, c8 = (lane & 3) * 8; const size_t o = (size_t)(row0 + 32 * tb + tl) * 512 + c0 + c8; float u[8], v[8]; ld8_act(F.U + o, u);
#pragma unroll
            for (int e = 0; e < 8; ++e) v[e] = u[e] * stg[tl * 33 + c8 + e];
            st8_act(F.YA + o, v); }
        LDS_WAIT();
    }
    __syncthreads();
}
__device__ __forceinline__ void gating_sample(Frame& F, int bs) {
    const int lane = F.lane; float vn[4][8];
#pragma unroll
    for (int t = 0; t < 4; ++t) { const int row = NP + bs * 4 + t; const float* vr = F.V + (size_t)row * 512; float s = 0.f;
#pragma unroll
        for (int j = 0; j < 8; ++j) { vn[t][j] = vr[lane + 64 * j]; s += vn[t][j]; }
        const float mean = wave_sum(s) * (1.0f / 512.0f); float q = 0.f;
#pragma unroll
        for (int j = 0; j < 8; ++j) { const float d = vn[t][j] - mean; q += d * d; }
        const float rstd = 1.0f / sqrtf(wave_sum(q) * (1.0f / 512.0f) + EPS);
#pragma unroll
        for (int j = 0; j < 8; ++j) { const int c = lane + 64 * j; vn[t][j] = (vn[t][j] - mean) * rstd * F.lng[c] + F.lnb[c]; F.out[O_VCH + (size_t)(bs * 4 + t) * 512 + c] = vn[t][j]; } }
#pragma unroll
    for (int t = 0; t < 4; ++t) { const int row = NP + bs * 4 + t;
#pragma unroll
        for (int j = 0; j < 8; ++j) { const int c = lane + 64 * j, g = j >> 1; float s = F.b_sp[g * 128 + t];
#pragma unroll
            for (int sp = 0; sp < 4; ++sp) if (sp <= t) s += F.w_sp[((size_t)g * 128 + t) * 128 + sp] * vn[sp][j];
            const size_t o = (size_t)row * 512 + c; st_act(F.YA + o, ld_act(F.U + o) * s); } }
}

__device__ __forceinline__ s16x4 vtr(const LAS bf16* p) { return __builtin_bit_cast(s16x4, __builtin_amdgcn_ds_read_tr16_b64_v4i16((LAS s16x4*)p)); }
constexpr int KTS = 72;
__device__ __forceinline__ void attn_tile(const LAS bf16* Kt, const LAS bf16* Vt, const bf16x8 (&qr)[4], unsigned valid0, unsigned valid1, float& m, float& l, f32x16 (&o)[2], LAS float* wsc, int lane) {
    const int r32 = lane & 31, hi = lane >> 5;
    f32x16 p0 = (f32x16){}, p1 = (f32x16){};
#pragma unroll
    for (int d0 = 0; d0 < 4; ++d0) {
        const bf16x8 k0 = *(const LAS bf16x8*)(Kt + r32 * KTS + 16 * d0 + 8 * hi), k1 = *(const LAS bf16x8*)(Kt + (32 + r32) * KTS + 16 * d0 + 8 * hi);
        p0 = __builtin_amdgcn_mfma_f32_32x32x16_bf16(k0, qr[d0], p0, 0, 0, 0); p1 = __builtin_amdgcn_mfma_f32_32x32x16_bf16(k1, qr[d0], p1, 0, 0, 0); }
    const bool full = (valid0 & valid1) == 0xffffu, none = (valid0 | valid1) == 0u;
    float mn, alpha, ls = 0.f;
    if (__all(full || none)) {
        float mt = fmaxf(fmaxf(p0[0], p0[1]), fmaxf(p1[0], p1[1]));
#pragma unroll
        for (int r = 2; r < 16; r += 2) mt = fmaxf(mt, fmaxf(fmaxf(p0[r], p0[r + 1]), fmaxf(p1[r], p1[r + 1])));
        mt = fmaxf(mt, __shfl_xor(mt, 32)); if (none) mt = NEGBIG;
        mn = fmaxf(m, mt); alpha = ex2(m - mn); m = mn;
        const float ms = none ? 1e30f : mn;
#pragma unroll
        for (int r = 0; r < 16; ++r) { p0[r] = ex2(p0[r] - ms); p1[r] = ex2(p1[r] - ms); ls += p0[r] + p1[r]; }
    } else {
        float mt = NEGBIG;
#pragma unroll
        for (int r = 0; r < 16; ++r) { if ((valid0 >> r) & 1u) mt = fmaxf(mt, p0[r]); if ((valid1 >> r) & 1u) mt = fmaxf(mt, p1[r]); }
        mt = fmaxf(mt, __shfl_xor(mt, 32));
        mn = fmaxf(m, mt); alpha = ex2(m - mn); m = mn;
#pragma unroll
        for (int r = 0; r < 16; ++r) { p0[r] = ((valid0 >> r) & 1u) ? ex2(p0[r] - mn) : 0.f; p1[r] = ((valid1 >> r) & 1u) ? ex2(p1[r] - mn) : 0.f; ls += p0[r] + p1[r]; }
    }
    ls += __shfl_xor(ls, 32); l = l * alpha + ls;
    if (!__all(alpha == 1.0f)) {
        if (hi == 0) wsc[96 + r32] = alpha;
        LDS_WAIT();
#pragma unroll
        for (int r = 0; r < 16; ++r) { const float a = wsc[96 + crow(r, hi)]; o[0][r] *= a; o[1][r] *= a; }
    }
    __builtin_amdgcn_sched_barrier(0);
    const int vrow = 4 * hi + ((lane & 15) >> 2), vcol = 16 * ((lane >> 4) & 1) + (lane & 3) * 4;
#pragma unroll
    for (int ph = 0; ph < 2; ++ph)
#pragma unroll
        for (int s = 0; s < 2; ++s) {
            const f32x16& pp = ph ? p1 : p0;
            const bf16x8 pa = pack8((f32x4){pp[8 * s], pp[8 * s + 1], pp[8 * s + 2], pp[8 * s + 3]}, (f32x4){pp[8 * s + 4], pp[8 * s + 5], pp[8 * s + 6], pp[8 * s + 7]});
#pragma unroll
            for (int db = 0; db < 2; ++db) {
                const LAS bf16* vp = Vt + (32 * ph + 16 * s + vrow) * KTS + 32 * db + vcol;
                const s16x4 lo = vtr(vp), hh = vtr(vp + 8 * KTS);
                const bf16x8 vb = (bf16x8){lo[0], lo[1], lo[2], lo[3], hh[0], hh[1], hh[2], hh[3]};
                o[db] = __builtin_amdgcn_mfma_f32_32x32x16_bf16(pa, vb, o[db], 0, 0, 0); }
        }
}
__device__ __forceinline__ void attn_prompt_unit(Frame& F, int b, int kvh, int j) {
    constexpr int OFF_KT = 0, OFF_VT = 18432, OFF_WSC = 36864, OFF_KCT = 40960, OFF_VCT = 45568, OFF_IMPS = 50176, OFF_MASK = OFF_IMPS + 64 * 33 * 4, OFF_MOR = OFF_MASK + 256, OFF_TL = OFF_MOR + 16, OFF_STASH = 59392;
    LAS bf16* KT = (LAS bf16*)(F.lds + OFF_KT); LAS bf16* VT = (LAS bf16*)(F.lds + OFF_VT); LAS bf16* KCT = (LAS bf16*)(F.lds + OFF_KCT); LAS bf16* VCT = (LAS bf16*)(F.lds + OFF_VCT);
    LAS float* IMPS = (LAS float*)(F.lds + OFF_IMPS); LAS unsigned* MASK = (LAS unsigned*)(F.lds + OFF_MASK); LAS unsigned* MOR = (LAS unsigned*)(F.lds + OFF_MOR); LAS int* TL = (LAS int*)(F.lds + OFF_TL);
    const int tid = F.tid, lane = F.lane, w = F.wave, r32 = lane & 31, hi = lane >> 5, g = w & 3, qs = w >> 2, h = kvh * 4 + g;
    LAS float* wsc = (LAS float*)(F.lds + OFF_WSC) + w * 128;
    LAS float* stash = (LAS float*)(F.lds + OFF_STASH) + w * 2048 + lane;
    const int row0 = b * TP + 64 * j, tq = 32 * qs + r32, t = 64 * j + tq, qrow = row0 + tq;
    bf16x8 qr[4];
#pragma unroll
    for (int d0 = 0; d0 < 4; ++d0) qr[d0] = *(const bf16x8*)(F.Q + (size_t)qrow * 512 + h * 64 + 16 * d0 + 8 * hi);
    { const int n = tid >> 4, d4 = (tid & 15) * 4; const size_t o = ((size_t)(b * 32 + n) * 2 + kvh) * 64 + d4; const f32x4 kc = *(const f32x4*)(F.KCP + o), vc = *(const f32x4*)(F.VCP + o);
      v2u a; a.x = pk2(kc[0], kc[1]); a.y = pk2(kc[2], kc[3]); *(LAS v2u*)(KCT + n * KTS + d4) = a; a.x = pk2(vc[0], vc[1]); a.y = pk2(vc[2], vc[3]); *(LAS v2u*)(VCT + n * KTS + d4) = a; }
    if (tid < 64) MASK[tid] = 0u;
    if (lane < 32) {
#pragma unroll
        for (int br = 0; br < 3; ++br) wsc[br * 32 + lane] = F.ZG[(size_t)(row0 + 32 * qs + lane) * 32 + br * 8 + h]; }
    __syncthreads();
    const int vrow = 4 * hi + ((lane & 15) >> 2), vcol = 16 * ((lane >> 4) & 1) + (lane & 3) * 4;
    {
        f32x16 pc = (f32x16){};
#pragma unroll
        for (int d0 = 0; d0 < 4; ++d0) pc = __builtin_amdgcn_mfma_f32_32x32x16_bf16(*(const LAS bf16x8*)(KCT + r32 * KTS + 16 * d0 + 8 * hi), qr[d0], pc, 0, 0, 0);
#if MK_DIAG_F32
        {
            const float* qf = F.QF + (size_t)qrow * 512 + h * 64;
#pragma unroll
            for (int r = 0; r < 16; ++r) { const float* kc = F.KCP + ((size_t)(b * 32 + crow(r, hi)) * 2 + kvh) * 64; float s = 0.f; for (int d = 0; d < 64; ++d) s += qf[d] * kc[d]; pc[r] = s; }
        }
#endif
        unsigned valid = 0u; float mt = NEGBIG;
#pragma unroll
        for (int r = 0; r < 16; ++r) { const int n = crow(r, hi); if ((n + 1) * 64 <= t + 1) { valid |= 1u << r; mt = fmaxf(mt, pc[r]); } }
        mt = fmaxf(mt, __shfl_xor(mt, 32)); float ls = 0.f;
#pragma unroll
        for (int r = 0; r < 16; ++r) { pc[r] = ((valid >> r) & 1u) ? ex2(pc[r] - mt) : 0.f; ls += pc[r]; }
        ls += __shfl_xor(ls, 32); const float inv = ls > 0.f ? 1.0f / ls : 0.f;
#pragma unroll
        for (int r = 0; r < 16; ++r) pc[r] *= inv;
        f32x16 oc[2]; oc[0] = (f32x16){}; oc[1] = (f32x16){};
#pragma unroll
        for (int s = 0; s < 2; ++s) {
            const bf16x8 pa = pack8((f32x4){pc[8 * s], pc[8 * s + 1], pc[8 * s + 2], pc[8 * s + 3]}, (f32x4){pc[8 * s + 4], pc[8 * s + 5], pc[8 * s + 6], pc[8 * s + 7]});
#pragma unroll
            for (int db = 0; db < 2; ++db) { const LAS bf16* vp = VCT + (16 * s + vrow) * KTS + 32 * db + vcol; const s16x4 lo = vtr(vp), hh = vtr(vp + 8 * KTS);
                oc[db] = __builtin_amdgcn_mfma_f32_32x32x16_bf16(pa, (bf16x8){lo[0], lo[1], lo[2], lo[3], hh[0], hh[1], hh[2], hh[3]}, oc[db], 0, 0, 0); } }
#pragma unroll
        for (int r = 0; r < 16; ++r) { const float gt = wsc[crow(r, hi)]; stash[r * 64] = oc[0][r] * gt; stash[(16 + r) * 64] = oc[1][r] * gt; }
        for (int gg = 0; gg < 4; ++gg) {
            if (g == gg) {
#pragma unroll
                for (int r = 0; r < 16; ++r) { LAS float* ip = IMPS + tq * 33 + crow(r, hi); *ip = (gg == 0 ? 0.f : *ip) + pc[r]; } }
            __syncthreads();
        }
    }
    for (int e = tid; e < 2048; e += NTHR) { const int q = e >> 5, n = e & 31; const float s = IMPS[q * 33 + n];
        IMPS[q * 33 + n] = (n == 0 || n == j || n == j - 1) ? 1e4f : (n > j ? -1.0f : s); }
    __syncthreads();
    { float an[4]; int rank[4];
#pragma unroll
      for (int c = 0; c < 4; ++c) { an[c] = IMPS[lane * 33 + 4 * w + c]; rank[c] = 0; }
#pragma unroll 8
      for (int mm = 0; mm < 32; ++mm) { const float am = IMPS[lane * 33 + mm];
#pragma unroll
          for (int c = 0; c < 4; ++c) rank[c] += (am > an[c] || (am == an[c] && mm < 4 * w + c)) ? 1 : 0; }
      unsigned bits = 0u;
#pragma unroll
      for (int c = 0; c < 4; ++c) if (rank[c] < 16) bits |= 1u << (4 * w + c);
      __hip_atomic_fetch_or(MASK + lane, bits, __ATOMIC_RELAXED, __HIP_MEMORY_SCOPE_WORKGROUP); }
    __syncthreads();
    if (w == 0) { unsigned v = MASK[lane];
#pragma unroll
        for (int o = 1; o < 64; o <<= 1) v |= (unsigned)__shfl_xor((int)v, o);
        if (lane == 0) { int n = 0; for (int jj = 0; jj <= j; ++jj) if ((v >> jj) & 1u) TL[1 + n++] = jj; const int nsel = n; const int jlo = j - 8 > 0 ? j - 8 : 0; for (int jj = j; jj >= jlo; --jj) TL[1 + n++] = 256 + jj; TL[0] = n | (nsel << 16); } }
    const unsigned mymask = MASK[tq];
    __syncthreads();
    const int ntile = TL[0] & 0xffff, nsel = TL[0] >> 16;
    const int ldkv = tid >> 3, ldch = (tid & 7) * 8;
    const size_t ldoff = (size_t)(b * TP + ldkv) * 256 + kvh * 64 + ldch;
    float m = NEGBIG, l = 0.f; f32x16 o[2]; o[0] = (f32x16){}; o[1] = (f32x16){};
    v4u kreg, vreg, kn;
    { const int e = TL[1]; const bf16* src = ((e >> 8) ? F.KVWB : F.KVSB) + ldoff + (size_t)(e & 255) * 64 * 256; kreg = *(const v4u*)src; vreg = *(const v4u*)(src + 128);
      const int e1 = TL[ntile > 1 ? 2 : 1]; const bf16* s1 = ((e1 >> 8) ? F.KVWB : F.KVSB) + ldoff + (size_t)(e1 & 255) * 64 * 256; kn = *(const v4u*)s1; }
    for (int k = 0; k < ntile; ++k) {
        const int e = TL[1 + k], jj = e & 255, buf = k & 1; const bool win = (e >> 8) != 0;
        *(LAS v4u*)(KT + buf * 4608 + ldkv * KTS + ldch) = kreg; *(LAS v4u*)(VT + buf * 4608 + ldkv * KTS + ldch) = vreg;
        kreg = kn;
        { const int k1 = k + 1 < ntile ? k + 1 : ntile - 1, k2 = k + 2 < ntile ? k + 2 : ntile - 1; const int e1 = TL[1 + k1], e2 = TL[1 + k2];
          vreg = *(const v4u*)(((e1 >> 8) ? F.KVWB : F.KVSB) + ldoff + (size_t)(e1 & 255) * 64 * 256 + 128); kn = *(const v4u*)(((e2 >> 8) ? F.KVWB : F.KVSB) + ldoff + (size_t)(e2 & 255) * 64 * 256); }
        if (k == nsel) {
            const float li = l > 0.f ? 1.0f / l : 0.f;
            if (hi == 0) wsc[96 + r32] = li * wsc[32 + r32];
            LDS_WAIT();
#pragma unroll
            for (int r = 0; r < 16; ++r) { const float fct = wsc[96 + crow(r, hi)]; stash[r * 64] += o[0][r] * fct; stash[(16 + r) * 64] += o[1][r] * fct; }
            m = NEGBIG; l = 0.f; o[0] = (f32x16){}; o[1] = (f32x16){};
        }
        __syncthreads();
        unsigned v0 = 0xffffu, v1 = 0xffffu;
        if (!win && !((mymask >> jj) & 1u)) { v0 = 0u; v1 = 0u; }
        else if (jj == j) { v0 = 0u; v1 = 0u;
#pragma unroll
            for (int r = 0; r < 16; ++r) { if (crow(r, hi) <= tq) v0 |= 1u << r; if (32 + crow(r, hi) <= tq) v1 |= 1u << r; } }
        else if (win && jj == j - 8) { v0 = 0u; v1 = 0u;
#pragma unroll
            for (int r = 0; r < 16; ++r) { if (crow(r, hi) > tq) v0 |= 1u << r; if (32 + crow(r, hi) > tq) v1 |= 1u << r; } }
        attn_tile(KT + buf * 4608, VT + buf * 4608, qr, v0, v1, m, l, o, wsc, lane);
    }
    {   const float li = l > 0.f ? 1.0f / l : 0.f;
        if (hi == 0) wsc[96 + r32] = li * wsc[64 + r32];
        LDS_WAIT();
#pragma unroll
        for (int db = 0; db < 2; ++db)
#pragma unroll
            for (int r = 0; r < 16; ++r) st_act(F.YB + (size_t)(row0 + 32 * qs + crow(r, hi)) * 512 + h * 64 + 32 * db + r32, stash[(16 * db + r) * 64] + o[db][r] * wsc[96 + crow(r, hi)]);
    }
    __syncthreads();
}

#if MK_DIAG_F32
__device__ __forceinline__ void gating_chunk_ref(Frame& F, int chunk) {
    const int row0 = chunk * 128; LAS float* stats = (LAS float*)F.lds; LAS float* VN = stats + 256;
    for (int rr = 0; rr < 16; ++rr) { const float* vr = F.V + (size_t)(row0 + 16 * F.wave + rr) * 512; float x[8], s = 0.f;
#pragma unroll
        for (int j = 0; j < 8; ++j) { x[j] = vr[F.lane + 64 * j]; s += x[j]; }
        const float mean = wave_sum(s) * (1.0f / 512.0f); float q = 0.f;
#pragma unroll
        for (int j = 0; j < 8; ++j) { const float d = x[j] - mean; q += d * d; }
        const float rstd = 1.0f / sqrtf(wave_sum(q) * (1.0f / 512.0f) + EPS);
        if (F.lane == 0) { stats[2 * (16 * F.wave + rr)] = mean; stats[2 * (16 * F.wave + rr) + 1] = rstd; } }
    for (int g = 0; g < 4; ++g) {
        __syncthreads();
        for (int e = F.tid; e < 128 * 128; e += NTHR) { const int s = e >> 7, d = e & 127, c = g * 128 + d; VN[e] = (F.V[(size_t)(row0 + s) * 512 + c] - stats[2 * s]) * stats[2 * s + 1] * F.lng[c] + F.lnb[c]; }
        __syncthreads();
        const int d = F.tid & 127;
        for (int t = F.tid >> 7; t < 128; t += 4) { float acc = F.b_sp[g * 128 + t]; const float* wr = F.w_sp + ((size_t)g * 128 + t) * 128;
            for (int s = 0; s <= t; ++s) acc += wr[s] * VN[s * 128 + d];
            const size_t o = (size_t)(row0 + t) * 512 + g * 128 + d; st_act(F.YA + o, ld_act(F.U + o) * acc); }
    }
    __syncthreads();
}
__device__ __forceinline__ void attn_prompt_ref(Frame& F, int b, int kvh, int t) {
    const int row = b * TP + t, cur = t >> 6, lane = F.lane; const float* kvp = F.out + O_KVP + (size_t)b * TP * 512;
    const bool av = lane < 32 && (lane + 1) * 64 <= t + 1;
    float imp = 0.f, pc0 = 0.f, pc1 = 0.f, pc2 = 0.f, pc3 = 0.f;
    for (int g = 0; g < 4; ++g) { const float q = F.QF[(size_t)row * 512 + (kvh * 4 + g) * 64 + lane]; float sc = NEGBIG;
        for (int n = 0; n < 32; ++n) { const float s = wave_sum(q * F.KCP[((size_t)(b * 32 + n) * 2 + kvh) * 64 + lane]); if (lane == n) sc = s; }
        const float m = wave_max(av ? sc : NEGBIG); const float p = av ? ex2(sc - m) : 0.f; const float l = wave_sum(p); const float pn = p / fmaxf(l, 1e-30f);
        imp += pn; if (g == 0) pc0 = pn; else if (g == 1) pc1 = pn; else if (g == 2) pc2 = pn; else pc3 = pn; }
    float a = (lane == 0 || lane == cur || lane == cur - 1) ? 1e4f : (lane > cur ? -1.0f : imp); if (lane >= 32) a = -2.0f;
    int rank = 0; for (int mm = 0; mm < 32; ++mm) { const float am = __shfl(a, mm); rank += (am > a || (am == a && mm < lane)) ? 1 : 0; }
    const unsigned mask = (unsigned)(__ballot(lane < 32 && rank < 16) & 0xffffffffull);
    for (int g = 0; g < 4; ++g) { const int h = kvh * 4 + g; const float q = F.QF[(size_t)row * 512 + h * 64 + lane];
        const float g0 = F.ZG[(size_t)row * 32 + h], g1 = F.ZG[(size_t)row * 32 + 8 + h], g2 = F.ZG[(size_t)row * 32 + 16 + h];
        const float pc = g == 0 ? pc0 : (g == 1 ? pc1 : (g == 2 ? pc2 : pc3)); float o = 0.f;
        for (int n = 0; n < 32; ++n) o += __shfl(pc, n) * g0 * F.VCP[((size_t)(b * 32 + n) * 2 + kvh) * 64 + lane];
        { float m = NEGBIG; for (int kp = 0; kp <= t; ++kp) { if (!((mask >> (kp >> 6)) & 1u)) continue; m = fmaxf(m, wave_sum(q * kvp[(size_t)kp * 512 + 256 + kvh * 64 + lane])); }
          float l = 0.f, os = 0.f;
          for (int kp = 0; kp <= t; ++kp) { if (!((mask >> (kp >> 6)) & 1u)) continue; const float* kk = kvp + (size_t)kp * 512 + 256 + kvh * 64; const float pp = ex2(wave_sum(q * kk[lane]) - m); l += pp; os += pp * kk[128 + lane]; }
          o += os * (g1 / fmaxf(l, 1e-30f)); }
        { const int k0 = t - 511 > 0 ? t - 511 : 0; float m = NEGBIG; for (int kp = k0; kp <= t; ++kp) m = fmaxf(m, wave_sum(q * F.KVWF[(size_t)(b * TP + kp) * 256 + kvh * 64 + lane]));
          float l = 0.f, os = 0.f;
          for (int kp = k0; kp <= t; ++kp) { const float* kk = F.KVWF + (size_t)(b * TP + kp) * 256 + kvh * 64; const float pp = ex2(wave_sum(q * kk[lane]) - m); l += pp; os += pp * kk[128 + lane]; }
          o += os * (g2 / fmaxf(l, 1e-30f)); }
        st_act(F.YB + (size_t)row * 512 + h * 64 + lane, o);
    }
}
#endif
constexpr int SCS = 1088;
struct KeysCmp { const float* kc; const float* vc; __device__ __forceinline__ void operator()(int k, const float*& K, const float*& V) const { K = kc + (size_t)k * 128; V = vc + (size_t)k * 128; } };
struct KeysSel { const float* cache; const LAS int* listr; const float* newk; int kvh; __device__ __forceinline__ void operator()(int k, const float*& K, const float*& V) const {
    if (k < 960) { const size_t r = (size_t)listr[k >> 6] + (k & 63); K = cache + (r * 4 + 2) * 128 + kvh * 64; V = K + 128; } else { K = newk + (size_t)(k - 960) * 512; V = K + 128; } } };
struct KeysWin { const float* prev; const float* neww; int nprev, t; __device__ __forceinline__ void operator()(int k, const float*& K, const float*& V) const {
    if (k < nprev) { K = prev + (size_t)(t + 1 + k) * 256; V = K + 128; } else { K = neww + (size_t)(k - nprev) * 256; V = K + 128; } } };
template <bool WANT_IMP, class KeyFn> __device__ __forceinline__ float small_attn(Frame& F, const float (&q)[4][4], int nkeys, const KeyFn& keyfn) {
    LAS float* SC = (LAS float*)F.lds; LAS float* IMP = SC + 4 * SCS; LAS float* ML = IMP + 272; LAS float* PM = ML + 16; LAS float* PO = PM + 256;
    const int lane = F.lane, w = F.wave, kl = lane >> 4, dl = lane & 15;
    float m[4], l[4], o[4][4];
#pragma unroll
    for (int g = 0; g < 4; ++g) { m[g] = NEGBIG; l[g] = 0.f;
#pragma unroll
        for (int e = 0; e < 4; ++e) o[g][e] = 0.f; }
    for (int kb = 0; kb < nkeys; kb += 128) {
        f32x4 kv[4], vv[4]; bool ok[4];
#pragma unroll
        for (int u = 0; u < 4; ++u) { const int k = kb + 32 * u + w * 4 + kl; ok[u] = k < nkeys; kv[u] = (f32x4){0.f, 0.f, 0.f, 0.f}; vv[u] = kv[u];
            if (ok[u]) { const float *K, *V; keyfn(k, K, V); kv[u] = *(const f32x4*)(K + 4 * dl); vv[u] = *(const f32x4*)(V + 4 * dl); } }
#pragma unroll
        for (int u = 0; u < 4; ++u) { const int k = kb + 32 * u + w * 4 + kl;
#pragma unroll
            for (int g = 0; g < 4; ++g) { float s = (q[g][0] * kv[u][0] + q[g][1] * kv[u][1]) + (q[g][2] * kv[u][2] + q[g][3] * kv[u][3]);
                s += __shfl_xor(s, 1); s += __shfl_xor(s, 2); s += __shfl_xor(s, 4); s += __shfl_xor(s, 8);
                if (ok[u]) { if (WANT_IMP && dl == 0) SC[g * SCS + k] = s;
                    const float mn = fmaxf(m[g], s), sc = ex2(m[g] - mn), pp = ex2(s - mn); m[g] = mn; l[g] = l[g] * sc + pp;
#pragma unroll
                    for (int e = 0; e < 4; ++e) o[g][e] = o[g][e] * sc + pp * vv[u][e]; } } }
    }
    { const int grp = w * 4 + kl;
#pragma unroll
      for (int g = 0; g < 4; ++g) { if (dl == 0) { PM[(grp * 4 + g) * 2] = m[g]; PM[(grp * 4 + g) * 2 + 1] = l[g]; } *(LAS f32x4*)(PO + (grp * 4 + g) * 64 + 4 * dl) = (f32x4){o[g][0], o[g][1], o[g][2], o[g][3]}; } }
    __syncthreads();
    float res = 0.f;
    if (F.tid < 256) { const int g = F.tid >> 6, d = F.tid & 63; float M = NEGBIG;
        for (int grp = 0; grp < 32; ++grp) M = fmaxf(M, PM[(grp * 4 + g) * 2]);
        float L = 0.f;
        for (int grp = 0; grp < 32; ++grp) { const float f = ex2(PM[(grp * 4 + g) * 2] - M); L += PM[(grp * 4 + g) * 2 + 1] * f; res += PO[(grp * 4 + g) * 64 + d] * f; }
        const float inv = 1.0f / L; res *= inv; if (d == 0) { ML[g] = M; ML[4 + g] = inv; } }
    __syncthreads();
    if (WANT_IMP) { for (int k = F.tid; k < nkeys; k += NTHR) IMP[k] = (ex2(SC[k] - ML[0]) * ML[4] + ex2(SC[SCS + k] - ML[1]) * ML[5]) + (ex2(SC[2 * SCS + k] - ML[2]) * ML[6] + ex2(SC[3 * SCS + k] - ML[3]) * ML[7]);
        __syncthreads(); }
    return res;
}
__device__ __forceinline__ void attn_sample_unit(Frame& F, int bs, int t, int kvh) {
    LAS float* SC = (LAS float*)F.lds; LAS float* IMP = SC + 4 * SCS; LAS unsigned* FLG = (LAS unsigned*)(IMP + 272 + 16 + 256 + 32 * 4 * 64); LAS int* LISTR = (LAS int*)(FLG + 256);
    const int tid = F.tid, lane = F.lane, dl = lane & 15, row = NP + bs * 4 + t;
    float q[4][4];
#pragma unroll
    for (int g = 0; g < 4; ++g)
#pragma unroll
        for (int e = 0; e < 4; ++e) q[g][e] = F.QS[(size_t)(row - NP) * 512 + (kvh * 4 + g) * 64 + 4 * dl + e];
    const int hme = kvh * 4 + (tid >> 6);
    float gate[3];
#pragma unroll
    for (int br = 0; br < 3; ++br) gate[br] = tid < 256 ? F.ZG[(size_t)row * 32 + br * 8 + hme] : 0.f;
    const KeysCmp kc{F.KCS + ((size_t)bs * 256 * 2 + kvh) * 64, F.VCS + ((size_t)bs * 256 * 2 + kvh) * 64};
    float acc = gate[0] * small_attn<true>(F, q, 256, kc);
    if (tid >= 1 && tid <= 254) { const float a = IMP[tid]; int rank = 0; for (int mm = 1; mm <= 254; ++mm) { const float am = IMP[mm]; rank += (am > a || (am == a && mm < tid)) ? 1 : 0; } FLG[tid] = rank < 13 ? 1u : 0u; }
    if (tid == 0 || tid == 255) FLG[tid] = 0u;
    __syncthreads();
    if (tid < 256) { const int n = tid; const int ridx = F.ptab[bs * 128 + (n >> 1)] * 128 + (n & 1) * 64;
        if (n == 0) LISTR[0] = ridx; else if (n == 255) LISTR[14] = ridx; else if (FLG[n]) { int pos = 0; for (int mm = 1; mm < n; ++mm) pos += (int)FLG[mm]; LISTR[1 + pos] = ridx; } }
    __syncthreads();
    const KeysSel ksel{F.cache, LISTR, F.out + O_KVS + (size_t)(bs * 4) * 512 + 2 * 128 + kvh * 64, kvh};
    acc += gate[1] * small_attn<false>(F, q, 960 + t + 1, ksel);
    const KeysWin kwin{F.st_win + (size_t)bs * 512 * 256 + kvh * 64, F.out + O_WINS + ((size_t)bs * 512 + 508) * 256 + kvh * 64, 511 - t, t};
    acc += gate[2] * small_attn<false>(F, q, 512, kwin);
    if (tid < 256) st_act(F.YB + (size_t)row * 512 + hme * 64 + (tid & 63), acc);
    __syncthreads();
}

__global__ void __launch_bounds__(NTHR, 2) mk_fwd(Args args) {
    extern __shared__ __attribute__((aligned(16))) unsigned char lds_raw[];
    Frame F;
    F.lds = (LAS unsigned char*)lds_raw; F.tid = threadIdx.x; F.lane = F.tid & 63; F.wave = __builtin_amdgcn_readfirstlane(F.tid >> 6); F.G = gridDim.x; F.bid = blockIdx.x;
    F.x_p = (const float*)args.in[0]; F.x_s = (const float*)args.in[1]; F.cache = (const float*)args.in[2]; F.st_win = (const float*)args.in[3]; F.st_conv = (const float*)args.in[4]; F.ptab = (const int*)args.in[5];
    F.c_p = (const float*)args.in[6]; F.c_s = (const float*)args.in[7]; F.w_ada = (const float*)args.in[8]; F.b_ada = (const float*)args.in[9]; F.g1 = (const float*)args.in[10]; F.w_in = (const float*)args.in[11];
    F.lng = (const float*)args.in[12]; F.lnb = (const float*)args.in[13]; F.w_sp = (const float*)args.in[14]; F.b_sp = (const float*)args.in[15]; F.pe = (const float*)args.in[16]; F.cw1 = (const float*)args.in[17];
    F.cb1 = (const float*)args.in[18]; F.cw2 = (const float*)args.in[19]; F.cb2 = (const float*)args.in[20]; F.w_a = (const float*)args.in[21]; F.w_b = (const float*)args.in[22]; F.w_out = (const float*)args.in[23];
    F.g2 = (const float*)args.in[24]; F.w_up = (const float*)args.in[25]; F.w_conv = (const float*)args.in[26]; F.b_conv = (const float*)args.in[27]; F.w_dn = (const float*)args.in[28]; F.g_fin = (const float*)args.in[29];
    F.out = args.out; unsigned char* ws = args.ws; F.ws = ws;
    F.PRE = (float*)(ws + WS_PRE); F.UPS = (float*)(ws + WS_UPS); F.TAIL = (float*)(ws + WS_TAIL); F.HEAD = (float*)(ws + WS_HEAD); F.MOD = (float*)(ws + WS_MOD); F.B1P = (float*)(ws + WS_B1P); F.KCP = (float*)(ws + WS_KCP); F.VCP = (float*)(ws + WS_VCP); F.KCS = (float*)(ws + WS_KCS); F.VCS = (float*)(ws + WS_VCS);
    F.V = (float*)(ws + WS_V); F.ZG = (float*)(ws + WS_ZG); F.MIXF = (float*)(ws + WS_MIXF); F.X1 = (float*)(ws + WS_X1); F.X2 = (float*)(ws + WS_X2);
    F.WSB = (bf16*)(ws + WS_WSB); F.KVWF = (float*)(ws + WS_KVWF); F.QF = (float*)(ws + WS_QF); F.QS = (float*)(ws + WS_QS); F.W1L = (bf16*)(ws + WS_W1L); F.W1F = (bf16*)(ws + WS_W1F); F.WIN = (bf16*)(ws + WS_WIN); F.WA = (bf16*)(ws + WS_WA); F.WB = (bf16*)(ws + WS_WB); F.WOUT = (bf16*)(ws + WS_WOUT); F.WUP = (bf16*)(ws + WS_WUP); F.WDN = (bf16*)(ws + WS_WDN);
    F.Q = (bf16*)(ws + WS_Q); F.KVSB = (bf16*)(ws + WS_KVSB); F.KVWB = (bf16*)(ws + WS_KVWB);
    F.HN = (act_t*)(ws + WS_HN); F.U = (act_t*)(ws + WS_U); F.GAB = (act_t*)(ws + WS_GAB); F.YA = (act_t*)(ws + WS_YA); F.YB = (act_t*)(ws + WS_YB); F.MIX = (act_t*)(ws + WS_MIX); F.H2 = (act_t*)(ws + WS_H2);
    F.UP = (act_t*)(ws + WS_UP); F.ACT = (act_t*)(ws + WS_ACT);
    for (int u = F.tid; u < (LDS_BYTES - RING_BYTES) / 4; u += NTHR) ((LAS unsigned*)(F.lds + RING_BYTES))[u] = 0u;
    __syncthreads();
    unsigned* ctl = (unsigned*)(ws + WS_CTL);
    XcdBarrier bar; bar.bar = ctl + CW_BAR; bar.x = 0; bar.st = nullptr;
#if MK_N_LAUNCHES == 1
    bar = xcd_barrier_post(ctl + CW_BAR, (volatile LAS unsigned*)(F.lds + MISC_OFF) + 8);
#define GRID_BAR() xcd_barrier(bar)
#else
#define GRID_BAR() do {} while (0)
#endif
    const int lo = args.ph_lo, hi = args.ph_hi;
#ifndef MK_PH_MASK
#define MK_PH_MASK 0xffff
#endif
#define IN(k) (((MK_PH_MASK >> (k)) & 1) && lo <= (k) && (k) < hi)
#define SEAM(k) do { if (IN(k) && IN((k) + 1)) GRID_BAR(); } while (0)
#ifndef MK_REP_MASK
#define MK_REP_MASK 0
#endif
    const int gw = F.bid * NWV + F.wave, NGW = F.G * NWV;

    if (IN(0)) { p0_prologue(F); } SEAM(0);

    if (IN(1)) {
        for (int row = gw; row < NR; row += 4 * NGW) {
            const float* xr[4]; const float* sh[4]; const float* sc[4]; act_t* orow[4];
#pragma unroll
            for (int k = 0; k < 4; ++k) { const int r = row + k * NGW < NR ? row + k * NGW : row; const float* mod = F.MOD + (size_t)seq_of(r) * MODC; xr[k] = xrow_of(F, r); sh[k] = mod; sc[k] = mod + 1024; orow[k] = F.HN + (size_t)r * DM; }
            rms_rows<true, 4>(xr, F.g1, sh, sc, orow, F.lane); }
        for (size_t i = (size_t)F.bid * NTHR + F.tid; i < (size_t)NSB * 508 * 64; i += (size_t)F.G * NTHR) { const size_t bs = i / (508 * 64), r = i % (508 * 64);
            *(f32x4*)(F.out + O_WINS + bs * 512 * 256 + r * 4) = *(const f32x4*)(F.st_win + bs * 512 * 256 + 4 * 256 + r * 4); }
    }

    if (IN(2)) {
        for (int u = F.bid; u < NSB * 8; u += F.G) { const int bs = u >> 3, g8 = u & 7; const BaseSample bf{F.cache, F.ptab + bs * 128, 32 * g8};
            compress_unit<2, 64, false>(F, bf, 0, F.KCS + ((size_t)bs * 256 + 32 * g8) * 128, F.VCS + ((size_t)bs * 256 + 32 * g8) * 128, nullptr, 0, nullptr); }
    } SEAM(2);

    if (IN(3)) { const EpiIn E{F.ws, F.out}; run_gemm<true>(F, F.HN, F.w_in, 4376, MapIn(), F.WIN, INP, DM, 4376, E); } SEAM(3);

    if (IN(4)) {
#if MK_DIAG_F32 && MK_REF_GATING
        for (int c = F.bid; c < NP / 128; c += F.G) gating_chunk_ref(F, c);
#else
        for (int c = F.bid; c < NP / 64; c += F.G) gating_chunk(F, c >> 1, c & 1);
#endif
        for (int u = F.G - 1 - F.bid; u < NPB * 2 * 4; u += F.G) { const int grp = u >> 2, kq = u & 3; const BasePrompt bf{F.out + O_KVP + ((size_t)(grp >> 1) * TP + (grp & 1) * 1024) * 512};
            compress_unit<1, 16, true>(F, bf, 16 * kq, F.KCP + (size_t)grp * 16 * 128, F.VCP + (size_t)grp * 16 * 128, F.PRE + (size_t)grp * 4 * 4096, kq, ctl + CW_CMP + 64 * grp); }
        { const int sb = ((F.G - 65 - F.bid) % F.G + F.G) % F.G; for (int s = sb * NWV + F.wave; s < NSB; s += NGW) gating_sample(F, s); }
    } SEAM(4);

    if (IN(5)) {
        for (int u = F.bid; u < NSB * TS * 2; u += F.G) attn_sample_unit(F, u >> 3, (u >> 1) & 3, u & 1);
#if MK_DIAG_F32 && MK_REF_ATTN
        for (int i = gw; i < NP * 2; i += NGW) attn_prompt_ref(F, i >> 12, (i >> 11) & 1, i & 2047);
#else
        for (int p = F.bid; p < 256; p += F.G) { const int b = p >> 5, kvh = (p >> 4) & 1, jl = p & 15;
#pragma unroll 1
            for (int i = 0; i < 2; ++i) attn_prompt_unit(F, b, kvh, i ? jl : 31 - jl); }
#endif
    } SEAM(5);

    if (IN(6)) {
        { const EpiBrA E{F.MIXF, F.GAB}; run_gemm<false>(F, F.YA, F.w_a, DM, MapId(), F.WA, DM, AW, DM, E); }
        { const EpiBrB E{F.MIXF, F.GAB, F.MIX}; run_gemm<false>(F, F.YB, F.w_b, DM, MapId(), F.WB, DM, AW, DM, E); }
    } SEAM(6);

    if (IN(7)) { const EpiRes E{F.x_p, F.x_s, F.MOD, 2048, F.X1}; run_gemm<false>(F, F.MIX, F.w_out, DM, MapId(), F.WOUT, DM, DM, DM, E); } SEAM(7);

    if (IN(8)) { for (int row = gw; row < NR; row += 4 * NGW) {
            const float* xr[4]; const float* sh[4]; const float* sc[4]; act_t* orow[4];
#pragma unroll
            for (int k = 0; k < 4; ++k) { const int r = row + k * NGW < NR ? row + k * NGW : row; const float* mod = F.MOD + (size_t)seq_of(r) * MODC; xr[k] = F.X1 + (size_t)r * DM; sh[k] = mod + 3072; sc[k] = mod + 4096; orow[k] = F.H2 + (size_t)r * DM; }
            rms_rows<true, 4>(xr, F.g2, sh, sc, orow, F.lane); } } SEAM(8);

#if MK_DIAG_F32
    if (IN(9)) { const EpiUp E{F.UP, F.out}; run_gemm<true>(F, F.H2, F.w_up, UPC, MapId(), F.WUP, UPC, DM, UPC, E); } SEAM(9);
#else
    if (IN(9)) { const EpiUpConv E{F.ws, F.out, F.w_conv, F.b_conv, (LAS float*)(F.lds + RING_BYTES + 1024)};
        pg8::Gemm g{F.H2, F.WUP, NRP, UPC, DM}; pg8::StaticOrder S; S.init(NRP, UPC, F.G, F.bid); pg8::gemm_phase<EpiUpConv, pg8::StaticOrder, true, true>(F.lds, g, S, E); } SEAM(9);
#endif

#if !MK_DIAG_F32
    if (IN(10)) {
        for (int i = F.bid * NTHR + F.tid; i < 56 * 2 * (DFF / 8); i += F.G * NTHR) {
            const int j0 = (i % (DFF / 8)) * 8, rt = i / (DFF / 8), t = rt & 1, k7 = rt >> 1, pm = (k7 / 7) * 8 + 1 + (k7 % 7); const int na = 256 * (j0 >> 7) + (j0 & 127);
            const float* h0 = F.HEAD + ((size_t)pm * 2) * UPC; const float* tl = F.TAIL + ((size_t)(pm - 1) * 2) * UPC;
            const float* r2p = t ? h0 + UPC : h0; const float* r1p = t ? h0 : tl + UPC; const float* r0p = t ? tl + UPC : tl; float o[8], ca[8], cg[8];
#pragma unroll
            for (int hf = 0; hf < 2; ++hf) { const int nn = na + hf * 128, j = j0 + hf * DFF; float w0[8], w1[8], w2[8], u0[8], u1[8], u2[8]; float* cc = hf ? cg : ca;
                ld8_f32(F.w_conv + j, w0); ld8_f32(F.w_conv + UPC + j, w1); ld8_f32(F.w_conv + 2 * UPC + j, w2); ld8_f32(F.b_conv + j, cc); ld8_f32(r0p + nn, u0); ld8_f32(r1p + nn, u1); ld8_f32(r2p + nn, u2);
#pragma unroll
                for (int e = 0; e < 8; ++e) cc[e] += w0[e] * u0[e] + w1[e] * u1[e] + w2[e] * u2[e]; }
#pragma unroll
            for (int e = 0; e < 8; ++e) o[e] = gelu_t(ca[e]) * cg[e];
            st8_act(F.ACT + (size_t)(pm * 256 + t) * DFF + j0, o); }
        for (int i = F.bid * NTHR + F.tid; i < NS * (DFF / 8); i += F.G * NTHR) {
            const int rs = i / (DFF / 8), j0 = (i % (DFF / 8)) * 8, t = rs & 3, na = 256 * (j0 >> 7) + (j0 & 127); const float* pv = F.st_conv + (size_t)(rs >> 2) * 2 * UPC; float o[8], ca[8], cg[8];
#pragma unroll
            for (int hf = 0; hf < 2; ++hf) { const int nn = na + hf * 128, j = j0 + hf * DFF; float w0[8], w1[8], w2[8], u0[8], u1[8], u2[8]; float* cc = hf ? cg : ca;
                ld8_f32(F.w_conv + j, w0); ld8_f32(F.w_conv + UPC + j, w1); ld8_f32(F.w_conv + 2 * UPC + j, w2); ld8_f32(F.b_conv + j, cc); ld8_f32(F.UPS + (size_t)rs * UPC + nn, u2);
                if (t >= 1) ld8_f32(F.UPS + (size_t)(rs - 1) * UPC + nn, u1); else ld8_f32(pv + UPC + j, u1);
                if (t >= 2) ld8_f32(F.UPS + (size_t)(rs - 2) * UPC + nn, u0); else ld8_f32(pv + (size_t)t * UPC + j, u0);
                if (t >= 2) st8_f32(F.out + O_CONVS + ((size_t)(rs >> 2) * 2 + (t - 2)) * UPC + j, u2);
#pragma unroll
                for (int e = 0; e < 8; ++e) cc[e] += w0[e] * u0[e] + w1[e] * u1[e] + w2[e] * u2[e]; }
#pragma unroll
            for (int e = 0; e < 8; ++e) o[e] = gelu_t(ca[e]) * cg[e];
            st8_act(F.ACT + (size_t)(NP + rs) * DFF + j0, o); }
    } SEAM(10);
#else
    if (IN(10)) {
        for (int it = F.bid * NTHR + F.tid; it < (NP / 64) * (DFF / 8); it += F.G * NTHR) {
            const int rc = it / (DFF / 8), j0 = (it % (DFF / 8)) * 8, row0 = rc * 64;
            float w0a[8], w1a[8], w2a[8], ba[8], w0g[8], w1g[8], w2g[8], bg[8], pa1[8], pa0[8], pg1[8], pg0[8];
            ld8_f32(F.w_conv + j0, w0a); ld8_f32(F.w_conv + UPC + j0, w1a); ld8_f32(F.w_conv + 2 * UPC + j0, w2a); ld8_f32(F.b_conv + j0, ba);
            ld8_f32(F.w_conv + DFF + j0, w0g); ld8_f32(F.w_conv + UPC + DFF + j0, w1g); ld8_f32(F.w_conv + 2 * UPC + DFF + j0, w2g); ld8_f32(F.b_conv + DFF + j0, bg);
            if ((row0 & (TP - 1)) == 0) {
#pragma unroll
                for (int e = 0; e < 8; ++e) { pa1[e] = 0.f; pa0[e] = 0.f; pg1[e] = 0.f; pg0[e] = 0.f; } }
            else { ld8_act(F.UP + (size_t)(row0 - 1) * UPC + j0, pa1); ld8_act(F.UP + (size_t)(row0 - 2) * UPC + j0, pa0); ld8_act(F.UP + (size_t)(row0 - 1) * UPC + DFF + j0, pg1); ld8_act(F.UP + (size_t)(row0 - 2) * UPC + DFF + j0, pg0); }
#pragma unroll 4
            for (int r = 0; r < 64; ++r) { const size_t ro = (size_t)(row0 + r) * UPC + j0; float ua[8], ug[8], o[8]; ld8_act(F.UP + ro, ua); ld8_act(F.UP + ro + DFF, ug);
#pragma unroll
                for (int e = 0; e < 8; ++e) { const float ca = ba[e] + w0a[e] * pa0[e] + w1a[e] * pa1[e] + w2a[e] * ua[e], cg = bg[e] + w0g[e] * pg0[e] + w1g[e] * pg1[e] + w2g[e] * ug[e];
                    o[e] = gelu_t(ca) * cg; pa0[e] = pa1[e]; pa1[e] = ua[e]; pg0[e] = pg1[e]; pg1[e] = ug[e]; }
                st8_act(F.ACT + (size_t)(row0 + r) * DFF + j0, o); }
        }
        for (int i = F.bid * NTHR + F.tid; i < NS * (DFF / 8); i += F.G * NTHR) {
            const int row = NP + i / (DFF / 8), j0 = (i % (DFF / 8)) * 8; float ca[8], cg[8], w0[8], w1[8], w2[8], u0[8], u1[8], u2[8];
            const int t = (row - NP) & 3; const float* pv = F.st_conv + (size_t)((row - NP) >> 2) * 2 * UPC;
#pragma unroll
            for (int hf = 0; hf < 2; ++hf) { const int j = j0 + hf * DFF; float* cc = hf ? cg : ca;
                ld8_f32(F.w_conv + j, w0); ld8_f32(F.w_conv + UPC + j, w1); ld8_f32(F.w_conv + 2 * UPC + j, w2); ld8_f32(F.b_conv + j, cc);
                ld8_act(F.UP + (size_t)row * UPC + j, u2);
                if (t >= 1) ld8_act(F.UP + (size_t)(row - 1) * UPC + j, u1); else ld8_f32(pv + UPC + j, u1);
                if (t >= 2) ld8_act(F.UP + (size_t)(row - 2) * UPC + j, u0); else ld8_f32(pv + (size_t)t * UPC + j, u0);
#pragma unroll
                for (int e = 0; e < 8; ++e) cc[e] += w0[e] * u0[e] + w1[e] * u1[e] + w2[e] * u2[e]; }
#pragma unroll
            for (int e = 0; e < 8; ++e) ca[e] = gelu_t(ca[e]) * cg[e];
            st8_act(F.ACT + (size_t)row * DFF + j0, ca); }
    } SEAM(10);
#endif

    if (IN(11)) { const EpiRes E{F.X1, F.X1 + (size_t)NP * DM, F.MOD, 5120, F.X2}; run_gemm<false>(F, F.ACT, F.w_dn, DM, MapId(), F.WDN, DM, DFF, DM, E); } SEAM(11);

    if (IN(12)) { for (int row = gw; row < NR; row += 4 * NGW) {
            const float* xr[4]; const float* sh[4]; const float* sc[4]; float* orow[4];
#pragma unroll
            for (int k = 0; k < 4; ++k) { const int r = row + k * NGW < NR ? row + k * NGW : row; xr[k] = F.X2 + (size_t)r * DM; sh[k] = nullptr; sc[k] = nullptr; orow[k] = r < NP ? F.out + O_YP + (size_t)r * DM : F.out + O_YS + (size_t)(r - NP) * DM; }
            rms_rows<false, 4>(xr, F.g_fin, sh, sc, orow, F.lane); } }
#undef IN
#undef SEAM
}

constexpr int NPHASES = 13;
extern "C" void kernel_launch(void* const* d_in, const int* in_sizes, int n_in, void* d_out, int out_size, void* d_ws, size_t ws_size, hipStream_t stream) {
    static int grid = 0;
    if (grid == 0) {
        if (n_in != 30 || out_size != (int)O_END || ws_size < WS_END) { fprintf(stderr, "kernel_launch: unexpected problem shape (n_in %d, out %d, ws %zu < %zu)\n", n_in, out_size, ws_size, (size_t)WS_END); grid = -1; return; }
        int dev = 0, cus = 0;
        if (hipGetDevice(&dev) != hipSuccess || hipDeviceGetAttribute(&cus, hipDeviceAttributeMultiprocessorCount, dev) != hipSuccess) { grid = -1; return; }
        if (hipFuncSetAttribute((const void*)mk_fwd, hipFuncAttributeMaxDynamicSharedMemorySize, LDS_BYTES) != hipSuccess) { fprintf(stderr, "kernel_launch: hipFuncSetAttribute failed\n"); grid = -1; return; }
        int per_cu = 0;
        if (hipOccupancyMaxActiveBlocksPerMultiprocessor(&per_cu, (const void*)mk_fwd, NTHR, LDS_BYTES) != hipSuccess || per_cu < 1) { fprintf(stderr, "kernel_launch: occupancy query says %d blocks per CU\n", per_cu); }
        (void)hipGetLastError();
        grid = cus;
    }
    if (grid < 0) return;
    (void)hipMemsetAsync((char*)d_ws + WS_CTL, 0, CTL_ZERO_BYTES, stream);
    Args a{};
    for (int i = 0; i < 30; ++i) a.in[i] = d_in[i];
    a.out = (float*)d_out; a.ws = (unsigned char*)d_ws; a.li = 0; a.pad = 0;
#if MK_N_LAUNCHES == 1
    a.ph_lo = 0; a.ph_hi = NPHASES;
    hipLaunchKernelGGL(mk_fwd, dim3(grid), dim3(NTHR), LDS_BYTES, stream, a);
#else
    for (int p = 0; p < NPHASES; ++p) { a.ph_lo = p; a.ph_hi = p + 1; const int nrep = ((MK_REP_MASK >> p) & 1) ? 3 : 1;
        for (int r = 0; r < nrep; ++r) hipLaunchKernelGGL(mk_fwd, dim3(grid), dim3(NTHR), LDS_BYTES, stream, a); }
#endif
}
```
